# Optimizing an MI355X kernel written in HIP

```python
import jax, jax.numpy as jnp
from jax import lax
import numpy as np

D_MODEL = 2048
BATCH = 4
SEQ = 4096
DEPTH = 4

N_HEADS = 16
HEAD_DIM = 128
D_LIN = N_HEADS * HEAD_DIM
CONV_QKV = 4
CHUNK = 64
POOL_WINDOWS = (2, 4, 8, 16)
N_POOL_GROUPS = len(POOL_WINDOWS)
D_POOL = D_MODEL
POOL_GROUP_DIM = D_POOL // N_POOL_GROUPS
D_FF = 5632
CONV_FFN = 3
EPS = 1e-6
D_IN_PROJ = 4 * D_LIN + 2 * N_HEADS + D_POOL + 2 * D_MODEL

kernel_name = "hybrid_gdn_pool_convglu_trunk"


def rmsnorm(x, w):
    xf = x.astype(jnp.float32)
    y = xf * lax.rsqrt(jnp.mean(xf * xf, axis=-1, keepdims=True) + EPS)
    return (y * w.astype(jnp.float32)).astype(x.dtype)


def l2norm(x):
    xf = x.astype(jnp.float32)
    return xf * lax.rsqrt(jnp.sum(xf * xf, axis=-1, keepdims=True) + EPS)


def causal_dwconv(x, w):
    width = w.shape[0]
    seq = x.shape[1]
    xp = jnp.pad(x, ((0, 0), (width - 1, 0), (0, 0)))
    y = xp[:, 0:seq] * w[0]
    for j in range(1, width):
        y = y + xp[:, j:j + seq] * w[j]
    return y


def gated_delta_rule(q, k, v, g, beta):
    f32 = jnp.float32
    q, k, v, g, beta = (t.astype(f32) for t in (q, k, v, g, beta))
    bsz, seq, nh, dk = q.shape
    dv = v.shape[-1]
    pad = (-seq) % CHUNK
    if pad:
        q, k, v = (jnp.pad(t, ((0, 0), (0, pad), (0, 0), (0, 0))) for t in (q, k, v))
        g, beta = (jnp.pad(t, ((0, 0), (0, pad), (0, 0))) for t in (g, beta))
    n_chunks = (seq + pad) // CHUNK

    def to_chunks(t):
        return t.reshape(bsz, n_chunks, CHUNK, nh, t.shape[-1]).transpose(0, 3, 1, 2, 4)

    q, k, v = to_chunks(q), to_chunks(k), to_chunks(v)
    g = g.reshape(bsz, n_chunks, CHUNK, nh).transpose(0, 3, 1, 2)
    beta = beta.reshape(bsz, n_chunks, CHUNK, nh).transpose(0, 3, 1, 2)
    g = jnp.cumsum(g, axis=-1)

    tril = jnp.tril(jnp.ones((CHUNK, CHUNK), dtype=bool))
    strict = jnp.tril(jnp.ones((CHUNK, CHUNK), dtype=bool), k=-1)
    diff = g[..., :, None] - g[..., None, :]
    decay = jnp.exp(jnp.where(tril, diff, -jnp.inf))

    k_beta = k * beta[..., None]
    v_beta = v * beta[..., None]
    lmat = jnp.where(strict, jnp.einsum('bhnid,bhnjd->bhnij', k_beta, k) * decay, 0.0)
    amat = lmat + jnp.eye(CHUNK, dtype=f32)
    rhs = jnp.concatenate([v_beta, k_beta * jnp.exp(g)[..., None]], axis=-1)
    sol = lax.linalg.triangular_solve(amat, rhs, left_side=True, lower=True, unit_diagonal=True)
    u_val = sol[..., :dv]
    w_cum = sol[..., dv:]

    attn_intra = jnp.einsum('bhnid,bhnjd->bhnij', q, k) * decay
    q_decay = q * jnp.exp(g)[..., None]
    k_to_end = k * jnp.exp(g[..., -1:] - g)[..., None]
    chunk_decay = jnp.exp(g[..., -1])

    xs = tuple(jnp.moveaxis(t, 2, 0) for t in (u_val, w_cum, q_decay, attn_intra, k_to_end, chunk_decay))

    def step(state, inp):
        u_c, w_c, qd_c, at_c, ke_c, dec_c = inp
        v_new = u_c - jnp.einsum('bhcd,bhdv->bhcv', w_c, state)
        o_c = jnp.einsum('bhcd,bhdv->bhcv', qd_c, state) + jnp.einsum('bhij,bhjv->bhiv', at_c, v_new)
        state = state * dec_c[..., None, None] + jnp.einsum('bhcd,bhcv->bhdv', ke_c, v_new)
        return state, o_c

    state0 = jnp.zeros((bsz, nh, dk, dv), dtype=f32)
    _, o = lax.scan(step, state0, xs)
    o = o.transpose(1, 0, 3, 2, 4).reshape(bsz, n_chunks * CHUNK, nh, dv)
    return o[:, :seq]


def causal_multiscale_pool(u):
    seq = u.shape[1]
    uf = u.astype(jnp.float32)
    cs = jnp.pad(jnp.cumsum(uf, axis=1), ((0, 0), (1, 0), (0, 0), (0, 0)))
    t = jnp.arange(seq)
    outs = []
    for gi, win in enumerate(POOL_WINDOWS):
        hi = cs[:, 1:, gi]
        lo = cs[:, jnp.maximum(t + 1 - win, 0), gi]
        cnt = jnp.minimum(t + 1, win).astype(jnp.float32)
        outs.append((hi - lo) / cnt[None, :, None])
    pooled = jnp.stack(outs, axis=2)
    return (pooled - uf).astype(u.dtype)


def setup_inputs(seed: int = 0) -> dict:
    key = jax.random.key(seed)
    ks = jax.random.split(key, 20)
    f32 = jnp.float32

    def nrm(k, shape, scale):
        return jax.random.normal(k, shape, f32) * scale

    def gain(k, shape):
        return 1.0 + 0.02 * jax.random.normal(k, shape, f32)

    x = jax.random.normal(ks[0], (BATCH, SEQ, D_MODEL), f32)
    a_init = jax.random.uniform(ks[4], (DEPTH, N_HEADS), f32, 1.0, 16.0)
    dt = jnp.exp(jax.random.uniform(ks[5], (DEPTH, N_HEADS), f32, np.log(1e-3), np.log(1e-1)))
    dt_bias = dt + jnp.log(-jnp.expm1(-dt))
    return {
        "x": x,
        "norm_mix_w": gain(ks[1], (DEPTH, D_MODEL)),
        "w_in": nrm(ks[2], (DEPTH, D_MODEL, D_IN_PROJ), D_MODEL ** -0.5),
        "conv_qkv_w": nrm(ks[3], (DEPTH, CONV_QKV, 3 * D_LIN), CONV_QKV ** -0.5),
        "a_log": jnp.log(a_init),
        "dt_bias": dt_bias,
        "gdn_norm_w": gain(ks[6], (DEPTH, HEAD_DIM)),
        "pool_w": nrm(ks[7], (DEPTH, N_POOL_GROUPS, POOL_GROUP_DIM, POOL_GROUP_DIM), POOL_GROUP_DIM ** -0.5),
        "pool_scale": gain(ks[8], (DEPTH, D_POOL)),
        "w_out": nrm(ks[9], (DEPTH, D_MODEL, D_MODEL), D_MODEL ** -0.5),
        "norm_ffn_w": gain(ks[10], (DEPTH, D_MODEL)),
        "w_up": nrm(ks[11], (DEPTH, D_MODEL, 2 * D_FF), D_MODEL ** -0.5),
        "conv_ffn_w": nrm(ks[12], (DEPTH, CONV_FFN, D_FF), CONV_FFN ** -0.5),
        "conv_ffn_b": nrm(ks[13], (DEPTH, D_FF), 0.02),
        "w_down": nrm(ks[14], (DEPTH, D_FF, D_MODEL), D_FF ** -0.5),
        "norm_final_w": gain(ks[15], (D_MODEL,)),
    }


def reference(x, norm_mix_w, w_in, conv_qkv_w, a_log, dt_bias, gdn_norm_w, pool_w, pool_scale,
              w_out, norm_ffn_w, w_up, conv_ffn_w, conv_ffn_b, w_down, norm_final_w):
    bsz, seq, _ = x.shape
    splits = np.cumsum([D_LIN, D_LIN, D_LIN, D_LIN, N_HEADS, N_HEADS, D_POOL, D_MODEL]).tolist()
    for l in range(DEPTH):
        h = rmsnorm(x, norm_mix_w[l])
        proj = jnp.einsum('bsd,de->bse', h, w_in[l])
        q, k, v, z, b_raw, a_raw, p_in, g_a, g_b = jnp.split(proj, splits, axis=-1)

        qkv = jax.nn.silu(causal_dwconv(jnp.concatenate([q, k, v], axis=-1), conv_qkv_w[l]))
        q, k, v = jnp.split(qkv, 3, axis=-1)
        q = l2norm(q.reshape(bsz, seq, N_HEADS, HEAD_DIM)) * (HEAD_DIM ** -0.5)
        k = l2norm(k.reshape(bsz, seq, N_HEADS, HEAD_DIM))
        v = v.reshape(bsz, seq, N_HEADS, HEAD_DIM)
        beta = jax.nn.sigmoid(b_raw.astype(jnp.float32))
        g_log = -jnp.exp(a_log[l].astype(jnp.float32)) * jax.nn.softplus(
            a_raw.astype(jnp.float32) + dt_bias[l].astype(jnp.float32))
        o = gated_delta_rule(q, k, v, g_log, beta).astype(x.dtype)
        o = rmsnorm(o, gdn_norm_w[l]) * jax.nn.silu(z.reshape(bsz, seq, N_HEADS, HEAD_DIM))
        y_a = o.reshape(bsz, seq, D_LIN)

        pooled = causal_multiscale_pool(p_in.reshape(bsz, seq, N_POOL_GROUPS, POOL_GROUP_DIM))
        y_b = jnp.einsum('bsgc,gcd->bsgd', pooled, pool_w[l]).reshape(bsz, seq, D_POOL) * pool_scale[l]

        mixed = jax.nn.sigmoid(g_a) * y_a + jax.nn.sigmoid(g_b) * y_b
        x = x + jnp.einsum('bsd,de->bse', mixed, w_out[l])

        h = rmsnorm(x, norm_ffn_w[l])
        gate, up = jnp.split(jnp.einsum('bsd,df->bsf', h, w_up[l]), 2, axis=-1)
        gate = causal_dwconv(gate, conv_ffn_w[l]) + conv_ffn_b[l]
        x = x + jnp.einsum('bsf,fd->bsd', jax.nn.gelu(gate, approximate=False) * up, w_down[l])
    return rmsnorm(x, norm_final_w)
```

```cpp
#include <hip/hip_runtime.h>
#include <cstdio>
#include <cstdint>

namespace pg8 {
#define PG8_LAS __attribute__((address_space(3)))
typedef unsigned short bf16_t;
typedef short bf16x8 __attribute__((ext_vector_type(8)));
typedef float f32x4 __attribute__((ext_vector_type(4)));
typedef unsigned u32x4 __attribute__((ext_vector_type(4)));
constexpr int BM = 256, BK = 64, HALF = 128, HTB = HALF * BK * 2  , STAGE_BYTES = 8 * HTB, NXCD = 8, WGM = 8;

__host__ __device__ __forceinline__ int lds_byte(int r, int c) { const int st = (r >> 4) * 2 + (c >> 5), rr = r & 15, cc = c & 31, ob = rr * 64 + cc * 2; return st * 1024 + (ob ^ (((ob >> 9) & 1) << 5)); }
__host__ __device__ __forceinline__ void stage_rc(int b, int& R, int& C) { const int st = b / 1024, sb = b % 1024, swz = sb ^ (((sb >> 9) & 1) << 5); R = (st >> 1) * 16 + swz / 64; C = (st & 1) * 32 + (swz % 64) / 2; }
__host__ __device__ __forceinline__ int perm32(int rho) { const int n = rho >> 4, i = rho & 15; return 8 * (i >> 2) + 4 * n + (i & 3); }

struct Unit { int pm, pn; };
struct Gemm { const bf16_t* A; const bf16_t* Bt; int M, N, K, lda, ldb, agrp; };

struct StaticOrder {
    int nM, nN, nwg, G, c;
    __host__ __device__ void init(int M, int N, int G_, int c_) { nM = M / BM; nN = N / BM; nwg = nM * nN; G = G_; c = c_; }
    __host__ __device__ bool next(int i, Unit& u) const {
        const long L = (long)i * G + c; if (L >= nwg) return false;
        int wgid = (int)L; { const int q = nwg / NXCD, r = nwg % NXCD, xcd = wgid % NXCD, off = wgid / NXCD; wgid = (xcd < r ? xcd * (q + 1) : r * (q + 1) + (xcd - r) * q) + off; }
        const int nig = WGM * nN, gid = wgid / nig, fm = gid * WGM, gsz = (nM - fm) < WGM ? (nM - fm) : WGM;
        u.pm = fm + ((wgid % nig) % gsz); u.pn = (wgid % nig) / gsz; return true;
    }
    __device__ __forceinline__ void a_ready(const Unit&) const {}
    __device__ __forceinline__ void done(const Unit&) const {}
};

__device__ __forceinline__ unsigned cvt_pk_bf16(float lo, float hi) { unsigned r; asm volatile("v_cvt_pk_bf16_f32 %0, %1, %2" : "=v"(r) : "v"(lo), "v"(hi)); return r; }
typedef float f32x2 __attribute__((ext_vector_type(2)));

struct EpiBf16 {
    static constexpr bool PERM = true, AFTER_DRAIN = false;
    bf16_t* O; int ldc;
    __device__ __forceinline__ void operator()(const f32x4 (&acc)[2][2][4][2], const Unit& u, int wr, int wc, int fr, int fq) const {
        const int row0 = u.pm * BM + wr * 64 + fr; const int col0 = u.pn * BM + wc * 32 + 8 * fq;
#pragma unroll
        for (int ai = 0; ai < 2; ++ai)
#pragma unroll
            for (int m = 0; m < 4; ++m) { bf16_t* rowp = O + (size_t)(row0 + ai * HALF + m * 16) * ldc + col0;
#pragma unroll
                for (int bj = 0; bj < 2; ++bj) { const f32x4 v0 = acc[ai][bj][m][0], v1 = acc[ai][bj][m][1];
                    u32x4 w; w.x = cvt_pk_bf16(v0[0], v0[1]); w.y = cvt_pk_bf16(v0[2], v0[3]); w.z = cvt_pk_bf16(v1[0], v1[1]); w.w = cvt_pk_bf16(v1[2], v1[3]);
                    *(u32x4*)(rowp + bj * HALF) = w; } }
    }
};
struct EpiResF32 {
    static constexpr bool PERM = false, AFTER_DRAIN = false;
    const float* base; float* out; int ldc;
    __device__ __forceinline__ void operator()(const f32x4 (&acc)[2][2][4][2], const Unit& u, int wr, int wc, int fr, int fq) const {
        const int row0 = u.pm * BM + wr * 64 + fr, col0 = u.pn * BM + wc * 32 + 4 * fq;
#pragma unroll
        for (int ai = 0; ai < 2; ++ai)
#pragma unroll
            for (int m = 0; m < 4; ++m) { const size_t off = (size_t)(row0 + ai * HALF + m * 16) * ldc + col0;
                f32x4 bs[2][2];
#pragma unroll
                for (int bj = 0; bj < 2; ++bj)
#pragma unroll
                    for (int n = 0; n < 2; ++n) bs[bj][n] = *(const f32x4*)(base + off + bj * HALF + n * 16);
#pragma unroll
                for (int bj = 0; bj < 2; ++bj)
#pragma unroll
                    for (int n = 0; n < 2; ++n) *(f32x4*)(out + off + bj * HALF + n * 16) = bs[bj][n] + acc[ai][bj][m][n];
                asm volatile("" ::: "memory"); }
    }
};

template <class Epi, class Sched, bool ALIGN_EPI = false, bool SP2 = false>
__device__ __forceinline__ void gemm_phase(PG8_LAS unsigned char* lds, const Gemm g, const Sched& S, const Epi& E) {
    const int tid = threadIdx.x, wid = __builtin_amdgcn_readfirstlane(tid >> 6), lane = tid & 63, wr = wid >> 2, wc = wid & 3, fr = lane & 15, fq = lane >> 4;
    const int K = g.K, nt = K / BK;
    unsigned voffA[2], voffB[2];
#pragma unroll
    for (int i = 0; i < 2; ++i) { int R, C; stage_rc(tid * 16 + i * 8192, R, C); const int Rb = Epi::PERM ? ((R & ~31) + perm32(R & 31)) : R;
        voffA[i] = (unsigned)(R * g.lda + C) * 2u; voffB[i] = (unsigned)(Rb * g.ldb + C) * 2u; }
    const size_t kstep = (size_t)(BK * 2);
    const size_t hsA = (size_t)HALF * g.lda * 2, hsB = (size_t)HALF * g.ldb * 2;
    const size_t tsA = 2 * hsA, tsB = 2 * hsB;
#define PG8_UA(u) ((const char*)g.A + (size_t)(u).pm * tsA + (g.agrp ? (size_t)((u).pn / g.agrp) * (size_t)K * 2 : (size_t)0))
#define PG8_UB(u) ((const char*)g.Bt + (size_t)(u).pn * tsB)
    const unsigned ldsw = (unsigned)wid * 1024u;
    const int aoff = lds_byte(wr * 64 + fr, fq * 8), boff = lds_byte(wc * 32 + fr, fq * 8);
#define PG8_SA(b, h) (((b) * 2 + (h)) * HTB)
#define PG8_SB(b, h) ((4 + (b) * 2 + (h)) * HTB)
#define PG8_STAGE(bufoff, gbase, voff) do { _Pragma("unroll") for (int _i = 0; _i < 2; ++_i) \
        __builtin_amdgcn_global_load_lds((const unsigned*)((const char*)(gbase) + (voff)[_i]), (PG8_LAS unsigned*)(lds + (bufoff) + ldsw + _i * 8192), 16, 0, 0); } while (0)
#define PG8_LDA(dst, b, h) do { _Pragma("unroll") for (int m = 0; m < 4; ++m) _Pragma("unroll") for (int k = 0; k < 2; ++k) dst[m][k] = *(const PG8_LAS bf16x8*)(lds + PG8_SA(b, h) + aoff + m * 2048 + k * 1024); } while (0)
#define PG8_LDB(dst, b, h) do { _Pragma("unroll") for (int n = 0; n < 2; ++n) _Pragma("unroll") for (int k = 0; k < 2; ++k) dst[n][k] = *(const PG8_LAS bf16x8*)(lds + PG8_SB(b, h) + boff + n * 2048 + k * 1024); } while (0)
#define PG8_MMA(ai, bj, At, Bt) do { __builtin_amdgcn_s_setprio(1); _Pragma("unroll") for (int m = 0; m < 4; ++m) _Pragma("unroll") for (int n = 0; n < 2; ++n) _Pragma("unroll") for (int k = 0; k < 2; ++k) \
        acc[ai][bj][m][n] = __builtin_amdgcn_mfma_f32_16x16x32_bf16(Bt[n][k], At[m][k], acc[ai][bj][m][n], 0, 0, 0); __builtin_amdgcn_s_setprio(0); } while (0)
#define PG8_WAIT_V(n) asm volatile("s_waitcnt vmcnt(" #n ")" ::: "memory")
#define PG8_WAIT_L(n) asm volatile("s_waitcnt lgkmcnt(" #n ")" ::: "memory")
#define PG8_BAR __builtin_amdgcn_s_barrier()
#define PG8_SCHED __builtin_amdgcn_sched_barrier(0)
    Unit cur, nxt; int ui = 0;
    if (!S.next(0, cur)) return;
    f32x4 acc[2][2][4][2];
#pragma unroll
    for (int a = 0; a < 2; ++a)
#pragma unroll
        for (int b = 0; b < 2; ++b)
#pragma unroll
            for (int m = 0; m < 4; ++m)
#pragma unroll
                for (int n = 0; n < 2; ++n) acc[a][b][m][n] = (f32x4){0.f, 0.f, 0.f, 0.f};
    bf16x8 At[4][2], B0[2][2], B1[2][2];
    const char* cA = PG8_UA(cur); const char* cB = PG8_UB(cur);
    S.a_ready(cur);
    if constexpr (SP2) {
        PG8_STAGE(PG8_SB(0, 0), cB, voffB); PG8_STAGE(PG8_SB(0, 1), cB + hsB, voffB); PG8_STAGE(PG8_SA(0, 0), cA, voffA); PG8_STAGE(PG8_SA(0, 1), cA + hsA, voffA);
        if (wr == 1) PG8_BAR;
        PG8_WAIT_V(2); PG8_BAR;
        PG8_STAGE(PG8_SB(1, 0), cB + kstep, voffB); PG8_STAGE(PG8_SA(1, 0), cA + kstep, voffA); PG8_STAGE(PG8_SB(1, 1), cB + hsB + kstep, voffB);
        PG8_WAIT_V(6); PG8_BAR;
    } else {
        PG8_STAGE(PG8_SB(0, 0), cB, voffB); PG8_STAGE(PG8_SA(0, 0), cA, voffA); PG8_STAGE(PG8_SB(0, 1), cB + hsB, voffB); PG8_STAGE(PG8_SA(0, 1), cA + hsA, voffA);
        if (wr == 1) PG8_BAR;
        PG8_WAIT_V(4); PG8_BAR;
        PG8_STAGE(PG8_SB(1, 0), cB + kstep, voffB); PG8_STAGE(PG8_SA(1, 0), cA + kstep, voffA); PG8_STAGE(PG8_SB(1, 1), cB + hsB + kstep, voffB);
        PG8_WAIT_V(6); PG8_BAR;
    }
    for (;;) {
        const bool has_next = S.next(ui + 1, nxt);
        const char* nA = has_next ? PG8_UA(nxt) : cA; const char* nB = has_next ? PG8_UB(nxt) : cB;
        for (int t = 0; t < nt; t += 2) {
            const bool last = (t == nt - 2);
            const char* a1 = cA + (size_t)(t + 1) * kstep;
            const char* a2 = last ? nA : cA + (size_t)(t + 2) * kstep; const char* b2 = last ? nB : cB + (size_t)(t + 2) * kstep;
            const char* a3 = a2 + kstep; const char* b3 = b2 + kstep;
            if (last && has_next) S.a_ready(nxt);
            if constexpr (SP2) {
            PG8_LDB(B0, 0, 0); PG8_LDB(B1, 0, 1); PG8_SCHED; PG8_LDA(At, 0, 0); PG8_STAGE(PG8_SA(1, 1), a1 + hsA, voffA);
            PG8_WAIT_V(8); PG8_WAIT_L(0); PG8_BAR; PG8_MMA(0, 0, At, B0); PG8_MMA(0, 1, At, B1); PG8_BAR; PG8_SCHED;
            PG8_LDA(At, 0, 1); PG8_STAGE(PG8_SB(0, 0), b2, voffB); PG8_STAGE(PG8_SB(0, 1), b2 + hsB, voffB); PG8_STAGE(PG8_SA(0, 0), a2, voffA);
            PG8_WAIT_V(8); PG8_WAIT_L(0); PG8_BAR; PG8_MMA(1, 0, At, B0); PG8_MMA(1, 1, At, B1); PG8_BAR; PG8_SCHED;
            PG8_LDB(B0, 1, 0); PG8_LDB(B1, 1, 1); PG8_SCHED; PG8_LDA(At, 1, 0); PG8_STAGE(PG8_SA(0, 1), a2 + hsA, voffA);
            PG8_WAIT_V(8); PG8_WAIT_L(0); PG8_BAR; PG8_MMA(0, 0, At, B0); PG8_MMA(0, 1, At, B1); PG8_BAR; PG8_SCHED;
            PG8_LDA(At, 1, 1); PG8_STAGE(PG8_SB(1, 0), b3, voffB); PG8_STAGE(PG8_SB(1, 1), b3 + hsB, voffB); PG8_STAGE(PG8_SA(1, 0), a3, voffA);
            PG8_WAIT_V(8); PG8_WAIT_L(0); PG8_BAR; PG8_MMA(1, 0, At, B0); PG8_MMA(1, 1, At, B1); PG8_BAR; PG8_SCHED;
            } else {
            PG8_LDB(B0, 0, 0); PG8_SCHED; PG8_LDA(At, 0, 0); PG8_STAGE(PG8_SA(1, 1), a1 + hsA, voffA);
            PG8_WAIT_L(8); PG8_BAR; PG8_WAIT_L(0); PG8_MMA(0, 0, At, B0); PG8_BAR; PG8_SCHED;
            PG8_LDB(B1, 0, 1); PG8_STAGE(PG8_SB(0, 0), b2, voffB);
            PG8_BAR; PG8_WAIT_L(0); PG8_MMA(0, 1, At, B1); PG8_BAR;
            PG8_LDA(At, 0, 1); PG8_STAGE(PG8_SA(0, 0), a2, voffA);
            PG8_BAR; PG8_WAIT_L(0); PG8_MMA(1, 0, At, B0); PG8_BAR; PG8_SCHED;
            PG8_STAGE(PG8_SB(0, 1), b2 + hsB, voffB);
            PG8_WAIT_V(6); PG8_BAR; PG8_MMA(1, 1, At, B1); PG8_BAR;
            PG8_LDB(B0, 1, 0); PG8_SCHED; PG8_LDA(At, 1, 0); PG8_STAGE(PG8_SA(0, 1), a2 + hsA, voffA);
            PG8_WAIT_L(8); PG8_BAR; PG8_WAIT_L(0); PG8_MMA(0, 0, At, B0); PG8_BAR; PG8_SCHED;
            PG8_LDB(B1, 1, 1); PG8_STAGE(PG8_SB(1, 0), b3, voffB);
            PG8_BAR; PG8_WAIT_L(0); PG8_MMA(0, 1, At, B1); PG8_BAR;
            PG8_LDA(At, 1, 1); PG8_STAGE(PG8_SA(1, 0), a3, voffA);
            PG8_BAR; PG8_WAIT_L(0); PG8_MMA(1, 0, At, B0); PG8_BAR; PG8_SCHED;
            PG8_STAGE(PG8_SB(1, 1), b3 + hsB, voffB);
            PG8_WAIT_V(6); PG8_BAR; PG8_MMA(1, 1, At, B1); PG8_BAR;
            }
        }
        if constexpr (ALIGN_EPI) { if (wr == 0) PG8_BAR; }
        if constexpr (!Epi::AFTER_DRAIN) { E(acc, cur, wr, wc, fr, fq); S.done(cur); }
        if (!has_next) break;
#pragma unroll
        for (int a = 0; a < 2; ++a)
#pragma unroll
            for (int b = 0; b < 2; ++b)
#pragma unroll
                for (int m = 0; m < 4; ++m)
#pragma unroll
                    for (int n = 0; n < 2; ++n) acc[a][b][m][n] = (f32x4){0.f, 0.f, 0.f, 0.f};
        cur = nxt; cA = nA; cB = nB; ++ui;
        if constexpr (ALIGN_EPI) { if (wr == 1) PG8_BAR; }
    }
    PG8_WAIT_V(0);
    if constexpr (!ALIGN_EPI) { if (wr == 0) PG8_BAR; }
    PG8_BAR;
    if constexpr (Epi::AFTER_DRAIN) { E.fused(acc, cur, wr, wc, fr, fq, lds, wid, lane); S.done(cur); }
#undef PG8_UA
#undef PG8_UB
#undef PG8_SA
#undef PG8_SB
#undef PG8_STAGE
#undef PG8_LDA
#undef PG8_LDB
#undef PG8_MMA
#undef PG8_WAIT_V
#undef PG8_WAIT_L
#undef PG8_BAR
#undef PG8_SCHED
}
}

typedef unsigned short bf16;
typedef short bf16x8 __attribute__((ext_vector_type(8)));
typedef float f32x4 __attribute__((ext_vector_type(4)));
typedef unsigned v4u __attribute__((ext_vector_type(4)));
typedef unsigned v2u __attribute__((ext_vector_type(2)));
#define LAS __attribute__((address_space(3)))
#define DI __device__ __forceinline__
constexpr int D = 2048, BATCH = 4, SEQ = 4096, DEPTH = 4, NH = 16, HD = 128, DFF = 5632;
constexpr int M = BATCH * SEQ;
constexpr int NPROJ = 14336;
constexpr int NIN = 14368;
constexpr int C_Q = 0, C_K = 2048, C_V = 4096, C_Z = 6144, C_P = 8192, C_GA = 10240, C_GB = 12288;
constexpr float EPS = 1e-6f;
constexpr int NWAVES = 8, NTHREADS = 512;

constexpr size_t MiB = 1u << 20;
constexpr size_t WS_CTL = 0;
constexpr size_t WS_WIN = 1 * MiB;
constexpr size_t WS_WOUT = 226 * MiB;
constexpr size_t WS_WUP = 258 * MiB;
constexpr size_t WS_WDN = 434 * MiB;
constexpr size_t WS_WPL = 522 * MiB;
constexpr size_t WS_H = 530 * MiB;
constexpr size_t WS_BA = 594 * MiB;
constexpr size_t WS_BETA = 596 * MiB;
constexpr size_t WS_G = 597 * MiB;
constexpr size_t WS_PROJ = 598 * MiB;
constexpr size_t WS_BIG2 = 1046 * MiB;
constexpr size_t WS_O = 1430 * MiB;
constexpr size_t WS_POOLED = 1558 * MiB;
constexpr size_t WS_YB = 1622 * MiB;
constexpr size_t WS_MIXED = 1686 * MiB;
constexpr size_t WS_END = 1750 * MiB;
static_assert(WS_WIN + (size_t)4 * NIN * D * 2 <= WS_WOUT && WS_WUP + (size_t)4 * 2 * DFF * D * 2 <= WS_WDN && WS_WDN + (size_t)4 * D * DFF * 2 <= WS_WPL, "ws map");
static_assert(WS_PROJ + (size_t)M * NPROJ * 2 <= WS_BIG2 && WS_BIG2 + (size_t)3 * M * D * 4 <= WS_O, "ws map");

struct Ctx { const float* in[16]; float* out; unsigned char* ws; };
enum { I_X = 0, I_NMW, I_WIN, I_CQW, I_ALOG, I_DTB, I_GNW, I_PW, I_PS, I_WOUT, I_NFW, I_WUP, I_CFW, I_CFB, I_WDN, I_NFIN };

DI float bf2f(bf16 b) { return __uint_as_float(((unsigned)b) << 16); }
DI unsigned f2bf(float f) { unsigned u = __float_as_uint(f); return (u + 0x7fffu + ((u >> 16) & 1u)) >> 16; }
DI unsigned pk2(float lo, float hi) { return f2bf(lo) | (f2bf(hi) << 16); }
DI float lo16(unsigned w) { return __uint_as_float(w << 16); }
DI float hi16(unsigned w) { return __uint_as_float(w & 0xffff0000u); }
DI float wave_sum(float v) {
#pragma unroll
    for (int o = 1; o < 64; o <<= 1) v += __shfl_xor(v, o);
    return v;
}
DI float sigmoidf_(float x) { return 1.0f / (1.0f + expf(-x)); }
DI float siluf_(float x) { return x / (1.0f + expf(-x)); }
DI float softplusf_(float x) { return fmaxf(x, 0.f) + log1pf(expf(-fabsf(x))); }
DI float gelu_erf(float x) { return 0.5f * x * (1.0f + erff(x * 0.70710678118654752f)); }

DI void transpose_item(const float* W, int ldw, int src_col0, int k0, bf16* WT, int K, int dst_row0, LAS float* scr, int lane) {
#pragma unroll 8
    for (int i = 0; i < 32; ++i) { const int kk = 2 * i + (lane >> 5); scr[kk * 33 + (lane & 31)] = W[(size_t)(k0 + kk) * ldw + src_col0 + (lane & 31)]; }
    asm volatile("s_waitcnt lgkmcnt(0)" ::: "memory");
    const int c = lane & 7;
#pragma unroll
    for (int j = 0; j < 4; ++j) { const int n = (lane >> 3) + 8 * j; const LAS float* s = scr + (8 * c) * 33 + n;
        v4u o; o.x = pk2(s[0 * 33], s[1 * 33]); o.y = pk2(s[2 * 33], s[3 * 33]); o.z = pk2(s[4 * 33], s[5 * 33]); o.w = pk2(s[6 * 33], s[7 * 33]);
        *(v4u*)(WT + (size_t)(dst_row0 + n) * K + k0 + 8 * c) = o; }
    asm volatile("s_waitcnt lgkmcnt(0)" ::: "memory");
}
constexpr int IT_IN = (D / 64) * (NIN / 32), IT_OUT = (D / 64) * (D / 32), IT_UP = (D / 64) * (2 * DFF / 32), IT_DN = (DFF / 64) * (D / 32), IT_PL = 4 * (512 / 64) * (512 / 32);
constexpr int IT_LAYER = IT_IN + IT_OUT + IT_UP + IT_DN + IT_PL;
DI void ph_convert(const Ctx& c, LAS unsigned char* lds, int gw, int ngw, int wave, int lane) {
    LAS float* scr = (LAS float*)(lds + wave * 16384);
    for (int it = gw; it < DEPTH * IT_LAYER; it += ngw) {
        const int l = it / IT_LAYER; int r = it % IT_LAYER;
        if (r < IT_IN) { const int nblk = NIN / 32, kb = r / nblk, nb = r % nblk; const int n0 = 32 * nb;
            const int sc = n0 < 8192 ? n0 : (n0 < NPROJ ? n0 + 32 : 8192 + (n0 - NPROJ));
            transpose_item(c.in[I_WIN] + (size_t)l * D * NIN, NIN, sc, 64 * kb, (bf16*)(c.ws + WS_WIN) + (size_t)l * NIN * D, D, n0, scr, lane); continue; }
        r -= IT_IN;
        if (r < IT_OUT) { const int nblk = D / 32, kb = r / nblk, nb = r % nblk;
            transpose_item(c.in[I_WOUT] + (size_t)l * D * D, D, 32 * nb, 64 * kb, (bf16*)(c.ws + WS_WOUT) + (size_t)l * D * D, D, 32 * nb, scr, lane); continue; }
        r -= IT_OUT;
        if (r < IT_UP) { const int nblk = 2 * DFF / 32, kb = r / nblk, nb = r % nblk;
            transpose_item(c.in[I_WUP] + (size_t)l * D * 2 * DFF, 2 * DFF, 32 * nb, 64 * kb, (bf16*)(c.ws + WS_WUP) + (size_t)l * 2 * DFF * D, D, 32 * nb, scr, lane); continue; }
        r -= IT_UP;
        if (r < IT_DN) { const int nblk = D / 32, kb = r / nblk, nb = r % nblk;
            transpose_item(c.in[I_WDN] + (size_t)l * DFF * D, D, 32 * nb, 64 * kb, (bf16*)(c.ws + WS_WDN) + (size_t)l * D * DFF, DFF, 32 * nb, scr, lane); continue; }
        r -= IT_DN;
        { const int g = r / 128, rr = r % 128, kb = rr / 16, nb = rr % 16;
            transpose_item(c.in[I_PW] + (size_t)(l * 4 + g) * 512 * 512, 512, 32 * nb, 64 * kb, (bf16*)(c.ws + WS_WPL) + (size_t)l * D * 512, 512, g * 512 + 32 * nb, scr, lane); }
    }
}

DI void ph_rmsnorm_bf16(const float* x, const float* w, bf16* out, int gw, int ngw, int lane) {
    for (int m = gw; m < M; m += ngw) {
        const f32x4* xr = (const f32x4*)(x + (size_t)m * D) + lane; f32x4 v[8]; float s = 0.f;
#pragma unroll
        for (int j = 0; j < 8; ++j) { v[j] = xr[64 * j]; s += (v[j].x * v[j].x + v[j].y * v[j].y) + (v[j].z * v[j].z + v[j].w * v[j].w); }
        const float rstd = 1.0f / sqrtf(wave_sum(s) * (1.0f / D) + EPS);
        v2u* o = (v2u*)(out + (size_t)m * D) + lane;
#pragma unroll
        for (int j = 0; j < 8; ++j) { const f32x4 ww = ((const f32x4*)w)[lane + 64 * j]; v2u p; p.x = pk2(v[j].x * rstd * ww.x, v[j].y * rstd * ww.y); p.y = pk2(v[j].z * rstd * ww.z, v[j].w * rstd * ww.w); o[64 * j] = p; }
    }
}
DI void ph_rmsnorm_f32(const float* x, const float* w, float* out, int gw, int ngw, int lane) {
    for (int m = gw; m < M; m += ngw) {
        const f32x4* xr = (const f32x4*)(x + (size_t)m * D) + lane; f32x4 v[8]; float s = 0.f;
#pragma unroll
        for (int j = 0; j < 8; ++j) { v[j] = xr[64 * j]; s += (v[j].x * v[j].x + v[j].y * v[j].y) + (v[j].z * v[j].z + v[j].w * v[j].w); }
        const float rstd = 1.0f / sqrtf(wave_sum(s) * (1.0f / D) + EPS);
        f32x4* o = (f32x4*)(out + (size_t)m * D) + lane;
#pragma unroll
        for (int j = 0; j < 8; ++j) { const f32x4 ww = ((const f32x4*)w)[lane + 64 * j]; o[64 * j] = (f32x4){v[j].x * rstd * ww.x, v[j].y * rstd * ww.y, v[j].z * rstd * ww.z, v[j].w * rstd * ww.w}; }
    }
}

DI void ph_ba(const Ctx& c, int l, int gw, int ngw, int lane) {
    const bf16* H = (const bf16*)(c.ws + WS_H); const bf16* Wt = (const bf16*)(c.ws + WS_WIN) + ((size_t)l * NIN + NPROJ) * D; float* BA = (float*)(c.ws + WS_BA);
    const int r = lane & 15, g = lane >> 4;
    for (int wt = gw; wt < M / 16; wt += ngw) {
        const bf16* ap = H + (size_t)(wt * 16 + r) * D + 8 * g; const bf16* b0p = Wt + (size_t)r * D + 8 * g; const bf16* b1p = Wt + (size_t)(16 + r) * D + 8 * g;
        f32x4 acc0 = {0.f, 0.f, 0.f, 0.f}, acc1 = {0.f, 0.f, 0.f, 0.f};
#pragma unroll 4
        for (int k0 = 0; k0 < D; k0 += 32) { const bf16x8 a = *(const bf16x8*)(ap + k0), b0 = *(const bf16x8*)(b0p + k0), b1 = *(const bf16x8*)(b1p + k0);
            acc0 = __builtin_amdgcn_mfma_f32_16x16x32_bf16(a, b0, acc0, 0, 0, 0); acc1 = __builtin_amdgcn_mfma_f32_16x16x32_bf16(a, b1, acc1, 0, 0, 0); }
#pragma unroll
        for (int j = 0; j < 4; ++j) { float* o = BA + (size_t)(wt * 16 + 4 * g + j) * 32; o[r] = acc0[j]; o[16 + r] = acc1[j]; }
    }
}

DI void ph_qkvconv_naive(const Ctx& c, int l, int gw, int ngw, int lane) {
    const bf16* P = (const bf16*)(c.ws + WS_PROJ); const float* cw = c.in[I_CQW] + (size_t)l * 4 * 3 * D;
    float* QN = (float*)(c.ws + WS_BIG2); float* KN = QN + (size_t)M * D; float* VN = KN + (size_t)M * D;
    for (int task = gw; task < M * NH; task += ngw) {
        const int m = task >> 4, hh = task & 15, t = m & (SEQ - 1);
#pragma unroll
        for (int sec = 0; sec < 3; ++sec) {
            const int col = sec * D + hh * HD + 2 * lane; float a0 = 0.f, a1 = 0.f;
#pragma unroll
            for (int j = 0; j < 4; ++j) { const int tt = t - 3 + j; if (tt >= 0) { const unsigned w = *(const unsigned*)(P + (size_t)(m - 3 + j) * NPROJ + col);
                    a0 += cw[(size_t)j * 3 * D + col] * lo16(w); a1 += cw[(size_t)j * 3 * D + col + 1] * hi16(w); } }
            a0 = siluf_(a0); a1 = siluf_(a1);
            float* dst = (sec == 0 ? QN : sec == 1 ? KN : VN) + (size_t)m * D + hh * HD + 2 * lane;
            if (sec < 2) { const float ss = wave_sum(a0 * a0 + a1 * a1); float sc = 1.0f / sqrtf(ss + EPS); if (sec == 0) sc *= 0.08838834764831845f; a0 *= sc; a1 *= sc; }
            dst[0] = a0; dst[1] = a1;
        }
        if (lane == 0) { const float* ba = (const float*)(c.ws + WS_BA) + (size_t)m * 32;
            ((float*)(c.ws + WS_BETA))[(size_t)m * 16 + hh] = sigmoidf_(ba[hh]);
            ((float*)(c.ws + WS_G))[(size_t)m * 16 + hh] = -expf(c.in[I_ALOG][l * NH + hh]) * softplusf_(ba[16 + hh] + c.in[I_DTB][l * NH + hh]); }
    }
}
DI void ph_gdn_naive(const Ctx& c, LAS unsigned char* lds, int unit0, int nunits_stride, int tid) {
    const float* QN = (const float*)(c.ws + WS_BIG2); const float* KN = QN + (size_t)M * D; const float* VN = KN + (size_t)M * D;
    const float* BETA = (const float*)(c.ws + WS_BETA); const float* G = (const float*)(c.ws + WS_G); float* O = (float*)(c.ws + WS_O);
    constexpr int TB = 16;
    LAS float* kl = (LAS float*)lds;
    LAS float* ql = kl + TB * 144;
    LAS float* vl = ql + TB * 144;
    LAS float* bl = vl + TB * 128;
    const int j = tid >> 2, p = tid & 3;
    for (int u = unit0; u < BATCH * NH; u += nunits_stride) {
        const int b = u >> 4, hh = u & 15; float S[32];
#pragma unroll
        for (int i = 0; i < 32; ++i) S[i] = 0.f;
        for (int t0 = 0; t0 < SEQ; t0 += TB) {
            __syncthreads();
            for (int e = tid; e < TB * 128; e += NTHREADS) { const int tt = e >> 7, cc = e & 127; const size_t gi = (size_t)(b * SEQ + t0 + tt) * D + hh * HD + cc;
                kl[tt * 144 + (cc >> 5) * 36 + (cc & 31)] = KN[gi]; ql[tt * 144 + (cc >> 5) * 36 + (cc & 31)] = QN[gi]; vl[tt * 128 + cc] = VN[gi]; }
            if (tid < TB) { const size_t gi = (size_t)(b * SEQ + t0 + tid) * 16 + hh; bl[tid * 2] = BETA[gi]; bl[tid * 2 + 1] = expf(G[gi]); }
            __syncthreads();
            for (int tt = 0; tt < TB; ++tt) {
                const float beta = bl[tt * 2], a = bl[tt * 2 + 1]; const LAS float* kp = kl + tt * 144 + p * 36; const LAS float* qp = ql + tt * 144 + p * 36;
                float kk[32]; float d = 0.f;
#pragma unroll
                for (int i = 0; i < 32; ++i) { kk[i] = kp[i]; d += S[i] * kk[i]; }
                d += __shfl_xor(d, 1); d += __shfl_xor(d, 2);
                const float vn = beta * (vl[tt * 128 + j] - a * d); float oo = 0.f;
#pragma unroll
                for (int i = 0; i < 32; ++i) { S[i] = a * S[i] + kk[i] * vn; oo += S[i] * qp[i]; }
                oo += __shfl_xor(oo, 1); oo += __shfl_xor(oo, 2);
                if (p == 0) O[(size_t)(b * SEQ + t0 + tt) * D + hh * HD + j] = oo;
            }
        }
    }
}
DI void ph_pooled(const Ctx& c, size_t gtid, size_t nthr) {
    const bf16* P = (const bf16*)(c.ws + WS_PROJ) + C_P; bf16* PO = (bf16*)(c.ws + WS_POOLED);
    for (size_t e = gtid; e < (size_t)M * (D / 2); e += nthr) {
        const int m = (int)(e >> 10), c2 = (int)(e & 1023), col = 2 * c2, gi = col >> 9, win = 2 << gi, t = m & (SEQ - 1), cnt = (t + 1) < win ? (t + 1) : win;
        float s0 = 0.f, s1 = 0.f, u0 = 0.f, u1 = 0.f;
        for (int s = 0; s < cnt; ++s) { const unsigned w = *(const unsigned*)(P + (size_t)(m - s) * NPROJ + col); const float x0 = lo16(w), x1 = hi16(w); if (s == 0) { u0 = x0; u1 = x1; } s0 += x0; s1 += x1; }
        const float inv = 1.0f / (float)cnt;
        *(unsigned*)(PO + (size_t)m * D + col) = pk2(s0 * inv - u0, s1 * inv - u1);
    }
}
DI void ph_mix_naive(const Ctx& c, int l, int gw, int ngw, int lane) {
    const bf16* P = (const bf16*)(c.ws + WS_PROJ); const float* O = (const float*)(c.ws + WS_O); const bf16* YB = (const bf16*)(c.ws + WS_YB); bf16* MX = (bf16*)(c.ws + WS_MIXED);
    const float* gnw = c.in[I_GNW] + l * HD; const float* ps = c.in[I_PS] + l * D;
    for (int m = gw; m < M; m += ngw) {
        for (int hh = 0; hh < NH; ++hh) {
            const int col = hh * HD + 2 * lane; const float o0 = O[(size_t)m * D + col], o1 = O[(size_t)m * D + col + 1];
            const float rstd = 1.0f / sqrtf(wave_sum(o0 * o0 + o1 * o1) * (1.0f / HD) + EPS);
            const unsigned z = *(const unsigned*)(P + (size_t)m * NPROJ + C_Z + col), ga = *(const unsigned*)(P + (size_t)m * NPROJ + C_GA + col), gb = *(const unsigned*)(P + (size_t)m * NPROJ + C_GB + col), yb = *(const unsigned*)(YB + (size_t)m * D + col);
            const float ya0 = o0 * rstd * gnw[2 * lane] * siluf_(lo16(z)), ya1 = o1 * rstd * gnw[2 * lane + 1] * siluf_(hi16(z));
            const float r0 = sigmoidf_(lo16(ga)) * ya0 + sigmoidf_(lo16(gb)) * lo16(yb) * ps[col], r1 = sigmoidf_(hi16(ga)) * ya1 + sigmoidf_(hi16(gb)) * hi16(yb) * ps[col + 1];
            *(unsigned*)(MX + (size_t)m * D + col) = pk2(r0, r1);
        }
    }
}
DI void ph_ffnact_naive(const Ctx& c, int l, size_t gtid, size_t nthr) {
    const bf16* GU = (const bf16*)(c.ws + WS_PROJ); bf16* ACT = (bf16*)(c.ws + WS_BIG2);
    const float* cw = c.in[I_CFW] + (size_t)l * 3 * DFF; const float* cb = c.in[I_CFB] + (size_t)l * DFF;
    for (size_t e = gtid; e < (size_t)M * (DFF / 2); e += nthr) {
        const int m = (int)(e / (DFF / 2)), f = 2 * (int)(e % (DFF / 2)), t = m & (SEQ - 1);
        float g0 = cb[f], g1 = cb[f + 1];
#pragma unroll
        for (int j = 0; j < 3; ++j) { const int tt = t - 2 + j; if (tt >= 0) { const unsigned w = *(const unsigned*)(GU + (size_t)(m - 2 + j) * (2 * DFF) + f); g0 += cw[j * DFF + f] * lo16(w); g1 += cw[j * DFF + f + 1] * hi16(w); } }
        const unsigned up = *(const unsigned*)(GU + (size_t)m * (2 * DFF) + DFF + f);
        *(unsigned*)(ACT + (size_t)m * DFF + f) = pk2(gelu_erf(g0) * lo16(up), gelu_erf(g1) * hi16(up));
    }
}

enum { PH_CONVERT = 0, PH_NORM_MIX, PH_BA, PH_GEMM_IN, PH_QKVCONV, PH_GDN, PH_POOLED, PH_GEMM_POOL, PH_MIX, PH_GEMM_OUT, PH_NORM_FFN, PH_GEMM_UP, PH_FFNACT, PH_GEMM_DN, PH_NORM_FINAL };
template <int PH> __global__ void __launch_bounds__(NTHREADS, 2) k_phase(Ctx c, int l) {
    extern __shared__ __attribute__((aligned(16))) unsigned char lds_raw[];
    LAS unsigned char* lds = (LAS unsigned char*)lds_raw;
    const int tid = threadIdx.x, lane = tid & 63, wave = __builtin_amdgcn_readfirstlane(tid >> 6);
    const int gw = blockIdx.x * NWAVES + wave, ngw = gridDim.x * NWAVES;
    const size_t gtid = (size_t)blockIdx.x * NTHREADS + tid, nthr = (size_t)gridDim.x * NTHREADS;
    float* X = c.out;
    if constexpr (PH == PH_CONVERT) ph_convert(c, lds, gw, ngw, wave, lane);
    if constexpr (PH == PH_NORM_MIX) ph_rmsnorm_bf16(l == 0 ? c.in[I_X] : X, c.in[I_NMW] + l * D, (bf16*)(c.ws + WS_H), gw, ngw, lane);
    if constexpr (PH == PH_BA) ph_ba(c, l, gw, ngw, lane);
    if constexpr (PH == PH_GEMM_IN) { pg8::Gemm g{(const bf16*)(c.ws + WS_H), (const bf16*)(c.ws + WS_WIN) + (size_t)l * NIN * D, M, NPROJ, D, D, D, 0};
        pg8::StaticOrder S; S.init(M, NPROJ, gridDim.x, blockIdx.x); pg8::EpiBf16 E{(bf16*)(c.ws + WS_PROJ), NPROJ};
        pg8::gemm_phase<pg8::EpiBf16, pg8::StaticOrder, true, true>(lds, g, S, E); }
    if constexpr (PH == PH_QKVCONV) ph_qkvconv_naive(c, l, gw, ngw, lane);
    if constexpr (PH == PH_GDN) ph_gdn_naive(c, lds, blockIdx.x, gridDim.x, tid);
    if constexpr (PH == PH_POOLED) ph_pooled(c, gtid, nthr);
    if constexpr (PH == PH_GEMM_POOL) { pg8::Gemm g{(const bf16*)(c.ws + WS_POOLED), (const bf16*)(c.ws + WS_WPL) + (size_t)l * D * 512, M, D, 512, D, 512, 2};
        pg8::StaticOrder S; S.init(M, D, gridDim.x, blockIdx.x); pg8::EpiBf16 E{(bf16*)(c.ws + WS_YB), D};
        pg8::gemm_phase<pg8::EpiBf16, pg8::StaticOrder, true, true>(lds, g, S, E); }
    if constexpr (PH == PH_MIX) ph_mix_naive(c, l, gw, ngw, lane);
    if constexpr (PH == PH_GEMM_OUT) { pg8::Gemm g{(const bf16*)(c.ws + WS_MIXED), (const bf16*)(c.ws + WS_WOUT) + (size_t)l * D * D, M, D, D, D, D, 0};
        pg8::StaticOrder S; S.init(M, D, gridDim.x, blockIdx.x); pg8::EpiResF32 E{l == 0 ? c.in[I_X] : X, X, D};
        pg8::gemm_phase<pg8::EpiResF32, pg8::StaticOrder, true, true>(lds, g, S, E); }
    if constexpr (PH == PH_NORM_FFN) ph_rmsnorm_bf16(X, c.in[I_NFW] + l * D, (bf16*)(c.ws + WS_H), gw, ngw, lane);
    if constexpr (PH == PH_GEMM_UP) { pg8::Gemm g{(const bf16*)(c.ws + WS_H), (const bf16*)(c.ws + WS_WUP) + (size_t)l * 2 * DFF * D, M, 2 * DFF, D, D, D, 0};
        pg8::StaticOrder S; S.init(M, 2 * DFF, gridDim.x, blockIdx.x); pg8::EpiBf16 E{(bf16*)(c.ws + WS_PROJ), 2 * DFF};
        pg8::gemm_phase<pg8::EpiBf16, pg8::StaticOrder, true, true>(lds, g, S, E); }
    if constexpr (PH == PH_FFNACT) ph_ffnact_naive(c, l, gtid, nthr);
    if constexpr (PH == PH_GEMM_DN) { pg8::Gemm g{(const bf16*)(c.ws + WS_BIG2), (const bf16*)(c.ws + WS_WDN) + (size_t)l * D * DFF, M, D, DFF, DFF, DFF, 0};
        pg8::StaticOrder S; S.init(M, D, gridDim.x, blockIdx.x); pg8::EpiResF32 E{X, X, D};
        pg8::gemm_phase<pg8::EpiResF32, pg8::StaticOrder, true, true>(lds, g, S, E); }
    if constexpr (PH == PH_NORM_FINAL) ph_rmsnorm_f32(X, c.in[I_NFIN], X, gw, ngw, lane);
}

constexpr int LDS_BYTES = 135168;
template <int PH> static void launch(const Ctx& c, int l, int grid, hipStream_t st) {
    static bool attr = false;
    if (!attr) { (void)hipFuncSetAttribute((const void*)k_phase<PH>, hipFuncAttributeMaxDynamicSharedMemorySize, LDS_BYTES); attr = true; }
    hipLaunchKernelGGL(k_phase<PH>, dim3(grid), dim3(NTHREADS), LDS_BYTES, st, c, l);
}

extern "C" void kernel_launch(void* const* d_in, const int* in_sizes, int n_in, void* d_out, int out_size, void* d_ws, size_t ws_size, hipStream_t stream) {
    if (n_in != 16 || out_size != M * D || ws_size < WS_END) { fprintf(stderr, "kernel_launch: unexpected shapes (n_in %d, out %d, ws %zu)\n", n_in, out_size, ws_size); return; }
    Ctx c{};
    for (int i = 0; i < 16; ++i) c.in[i] = (const float*)d_in[i];
    c.out = (float*)d_out; c.ws = (unsigned char*)d_ws;
    const int G = 256;
    launch<PH_CONVERT>(c, 0, G, stream);
    for (int l = 0; l < DEPTH; ++l) {
        launch<PH_NORM_MIX>(c, l, G, stream);
        launch<PH_BA>(c, l, G, stream);
        launch<PH_GEMM_IN>(c, l, G, stream);
        launch<PH_QKVCONV>(c, l, G, stream);
        launch<PH_GDN>(c, l, G, stream);
        launch<PH_POOLED>(c, l, G, stream);
        launch<PH_GEMM_POOL>(c, l, G, stream);
        launch<PH_MIX>(c, l, G, stream);
        launch<PH_GEMM_OUT>(c, l, G, stream);
        launch<PH_NORM_FFN>(c, l, G, stream);
        launch<PH_GEMM_UP>(c, l, G, stream);
        launch<PH_FFNACT>(c, l, G, stream);
        launch<PH_GEMM_DN>(c, l, G, stream);
    }
    launch<PH_NORM_FINAL>(c, 0, G, stream);
}
```

```cpp
#include <hip/hip_runtime.h>
#include <cstdio>
#include <cstdint>

namespace pg8 {
#define PG8_LAS __attribute__((address_space(3)))
typedef unsigned short bf16_t;
typedef short bf16x8 __attribute__((ext_vector_type(8)));
typedef float f32x4 __attribute__((ext_vector_type(4)));
typedef unsigned u32x4 __attribute__((ext_vector_type(4)));
constexpr int BM = 256, BK = 64, HALF = 128, HTB = HALF * BK * 2  , STAGE_BYTES = 8 * HTB, NXCD = 8, WGM = 8;

__host__ __device__ __forceinline__ int lds_byte(int r, int c) { const int st = (r >> 4) * 2 + (c >> 5), rr = r & 15, cc = c & 31, ob = rr * 64 + cc * 2; return st * 1024 + (ob ^ (((ob >> 9) & 1) << 5)); }
__host__ __device__ __forceinline__ void stage_rc(int b, int& R, int& C) { const int st = b / 1024, sb = b % 1024, swz = sb ^ (((sb >> 9) & 1) << 5); R = (st >> 1) * 16 + swz / 64; C = (st & 1) * 32 + (swz % 64) / 2; }
__host__ __device__ __forceinline__ int perm32(int rho) { const int n = rho >> 4, i = rho & 15; return 8 * (i >> 2) + 4 * n + (i & 3); }

struct Unit { int pm, pn; };
struct Gemm { const bf16_t* A; const bf16_t* Bt; int M, N, K, lda, ldb, agrp; };

struct StaticOrder {
    int nM, nN, nwg, G, c;
    __host__ __device__ void init(int M, int N, int G_, int c_) { nM = M / BM; nN = N / BM; nwg = nM * nN; G = G_; c = c_; }
    __host__ __device__ bool next(int i, Unit& u) const {
        const long L = (long)i * G + c; if (L >= nwg) return false;
        int wgid = (int)L; { const int q = nwg / NXCD, r = nwg % NXCD, xcd = wgid % NXCD, off = wgid / NXCD; wgid = (xcd < r ? xcd * (q + 1) : r * (q + 1) + (xcd - r) * q) + off; }
        const int nig = WGM * nN, gid = wgid / nig, fm = gid * WGM, gsz = (nM - fm) < WGM ? (nM - fm) : WGM;
        u.pm = fm + ((wgid % nig) % gsz); u.pn = (wgid % nig) / gsz; return true;
    }
    __device__ __forceinline__ void a_ready(const Unit&) const {}
    __device__ __forceinline__ void done(const Unit&) const {}
};

__device__ __forceinline__ unsigned cvt_pk_bf16(float lo, float hi) { unsigned r; asm volatile("v_cvt_pk_bf16_f32 %0, %1, %2" : "=v"(r) : "v"(lo), "v"(hi)); return r; }
typedef float f32x2 __attribute__((ext_vector_type(2)));

__device__ __forceinline__ float ss_val(unsigned long long v) { return ((float)(unsigned)(v >> 32) * 4294967296.0f + (float)(unsigned)v) * (1.0f / 1048576.0f); }
struct EpiBf16 {
    static constexpr bool PERM = true, AFTER_DRAIN = false;
    bf16_t* O; int ldc; const unsigned long long* ss; float inv_nk, eps;
    __device__ __forceinline__ void operator()(const f32x4 (&acc)[2][2][4][2], const Unit& u, int wr, int wc, int fr, int fq) const {
        const int row0 = u.pm * BM + wr * 64 + fr; const int col0 = u.pn * BM + wc * 32 + 8 * fq;
#pragma unroll
        for (int ai = 0; ai < 2; ++ai)
#pragma unroll
            for (int m = 0; m < 4; ++m) { const int row = row0 + ai * HALF + m * 16; bf16_t* rowp = O + (size_t)row * ldc + col0;
                const float rs = ss ? __builtin_amdgcn_rsqf(ss_val(ss[row]) * inv_nk + eps) : 1.0f;
#pragma unroll
                for (int bj = 0; bj < 2; ++bj) { const f32x4 v0 = acc[ai][bj][m][0] * rs, v1 = acc[ai][bj][m][1] * rs;
                    u32x4 w; w.x = cvt_pk_bf16(v0[0], v0[1]); w.y = cvt_pk_bf16(v0[2], v0[3]); w.z = cvt_pk_bf16(v1[0], v1[1]); w.w = cvt_pk_bf16(v1[2], v1[3]);
                    *(u32x4*)(rowp + bj * HALF) = w; } }
    }
};
struct EpiResF32 {
    static constexpr bool PERM = false, AFTER_DRAIN = false;
    const float* base; float* out; bf16_t* xb; unsigned long long* ss; int ldc;
    __device__ __forceinline__ void operator()(const f32x4 (&acc)[2][2][4][2], const Unit& u, int wr, int wc, int fr, int fq) const {
        const int row0 = u.pm * BM + wr * 64 + fr, col0 = u.pn * BM + wc * 32 + 4 * fq;
        typedef unsigned u32x2 __attribute__((ext_vector_type(2)));
#pragma unroll
        for (int ai = 0; ai < 2; ++ai)
#pragma unroll
            for (int m = 0; m < 4; ++m) { const int row = row0 + ai * HALF + m * 16; const size_t off = (size_t)row * ldc + col0;
                f32x4 bs[2][2]; float q = 0.f;
#pragma unroll
                for (int bj = 0; bj < 2; ++bj)
#pragma unroll
                    for (int n = 0; n < 2; ++n) bs[bj][n] = *(const f32x4*)(base + off + bj * HALF + n * 16);
#pragma unroll
                for (int bj = 0; bj < 2; ++bj)
#pragma unroll
                    for (int n = 0; n < 2; ++n) { const f32x4 o = bs[bj][n] + acc[ai][bj][m][n]; *(f32x4*)(out + off + bj * HALF + n * 16) = o;
                        u32x2 w; w.x = cvt_pk_bf16(o[0], o[1]); w.y = cvt_pk_bf16(o[2], o[3]); *(u32x2*)(xb + off + bj * HALF + n * 16) = w;
                        q += (o[0] * o[0] + o[1] * o[1]) + (o[2] * o[2] + o[3] * o[3]); }
                q += __shfl_xor(q, 16); q += __shfl_xor(q, 32);
                if (fq == 0) __hip_atomic_fetch_add(ss + row, (unsigned long long)(q * 1048576.0f + 0.5f), __ATOMIC_RELAXED, __HIP_MEMORY_SCOPE_AGENT);
                asm volatile("" ::: "memory"); }
    }
};
__device__ __forceinline__ f32x2 gelu_pk(f32x2 v) {
    const f32x2 av = __builtin_elementwise_abs(v), d = av * 0.2316418882f + 1.0f;
    f32x2 t; t.x = __builtin_amdgcn_rcpf(d.x); t.y = __builtin_amdgcn_rcpf(d.y);
    f32x2 q = t * 0.5307027145f + (-0.7265760135f); q = q * t + 0.7107068705f; q = q * t + (-0.142248368f); q = q * t + 0.127414796f; q = q * t;
    const f32x2 s = (v * v) * (-0.72134752044f);
    f32x2 e; e.x = __builtin_amdgcn_exp2f(s.x); e.y = __builtin_amdgcn_exp2f(s.y);
    const f32x2 m = v * (q * e), r = v - m;
    f32x2 o; o.x = v.x < 0.f ? m.x : r.x; o.y = v.y < 0.f ? m.y : r.y; return o;
}
template <int N> __device__ __forceinline__ float row_ror(float x) { return __builtin_bit_cast(float, __builtin_amdgcn_update_dpp(0, __builtin_bit_cast(int, x), 0x120 + N, 0xf, 0xf, false)); }
struct EpiGlu {
    static constexpr bool PERM = true, AFTER_DRAIN = false;
    bf16_t* ACT; const float* cw; const float* cb; float* edge; PG8_LAS float* xb; int dff; const unsigned long long* ss; float inv_nk, eps;
    __device__ __forceinline__ void operator()(const f32x4 (&acc_)[2][2][4][2], const Unit& u, int wr, int wc, int fr, int fq) const {
        f32x4 acc[2][2][4][2];
#pragma unroll
        for (int ai = 0; ai < 2; ++ai)
#pragma unroll
            for (int m = 0; m < 4; ++m) { const float rs = __builtin_amdgcn_rsqf(ss_val(ss[u.pm * BM + ai * HALF + wr * 64 + m * 16 + fr]) * inv_nk + eps);
#pragma unroll
                for (int bj = 0; bj < 2; ++bj)
#pragma unroll
                    for (int n = 0; n < 2; ++n) acc[ai][bj][m][n] = acc_[ai][bj][m][n] * rs; }
        const int f0 = u.pn * 128 + wc * 32 + 8 * fq;
        if (fr >= 14) {
#pragma unroll
            for (int ai = 0; ai < 2; ++ai) { PG8_LAS f32x4* p = (PG8_LAS f32x4*)(xb + ((((wr * 2 + ai) * 4 + wc) * 2 + (fr - 14)) * 32 + 8 * fq)); p[0] = acc[ai][0][3][0]; p[1] = acc[ai][0][3][1]; }
        }
        asm volatile("s_waitcnt lgkmcnt(0)" ::: "memory"); __builtin_amdgcn_s_barrier(); asm volatile("" ::: "memory");
        f32x4 w0[2], w1[2], w2[2], bb[2];
#pragma unroll
        for (int n = 0; n < 2; ++n) { w0[n] = *(const f32x4*)(cw + f0 + 4 * n); w1[n] = *(const f32x4*)(cw + dff + f0 + 4 * n); w2[n] = *(const f32x4*)(cw + 2 * dff + f0 + 4 * n); bb[n] = *(const f32x4*)(cb + f0 + 4 * n); }
        const bool seq_start = (u.pm & 15) == 0;
#pragma unroll
        for (int ai = 0; ai < 2; ++ai) {
            f32x4 pr1[2], pr2[2];
            if (wr == 1 || ai == 1) { const int swr = (wr == 1) ? 0 : 1, sai = (wr == 1) ? ai : 0; const PG8_LAS f32x4* p = (const PG8_LAS f32x4*)(xb + ((((swr * 2 + sai) * 4 + wc) * 2) * 32 + 8 * fq));
                const f32x4 a0 = p[0], a1 = p[1], b0 = p[8], b1 = p[9]; pr1[0] = b0; pr1[1] = b1; pr2[0] = (fr == 0) ? a0 : b0; pr2[1] = (fr == 0) ? a1 : b1; }
            else { pr1[0] = pr1[1] = pr2[0] = pr2[1] = (f32x4){0.f, 0.f, 0.f, 0.f}; }
            const bool defer_blk = (ai == 0) && (wr == 0) && !seq_start;
#pragma unroll
            for (int m = 0; m < 4; ++m) {
                const int row = u.pm * BM + ai * HALF + wr * 64 + m * 16 + fr; u32x4 w;
#pragma unroll
                for (int n = 0; n < 2; ++n) { const f32x4 g = acc[ai][0][m][n], up = acc[ai][1][m][n]; f32x4 r1, r2, a;
                    r1[0] = row_ror<1>(g[0]); r1[1] = row_ror<1>(g[1]); r1[2] = row_ror<1>(g[2]); r1[3] = row_ror<1>(g[3]);
                    r2[0] = row_ror<2>(g[0]); r2[1] = row_ror<2>(g[1]); r2[2] = row_ror<2>(g[2]); r2[3] = row_ror<2>(g[3]);
#pragma unroll
                    for (int e = 0; e < 4; ++e) { const float p1 = (fr >= 1) ? r1[e] : pr1[n][e], p2 = (fr >= 2) ? r2[e] : pr2[n][e]; a[e] = w0[n][e] * p2 + w1[n][e] * p1 + w2[n][e] * g[e] + bb[n][e]; }
                    pr1[n] = r1; pr2[n] = r2;
                    const f32x2 x0 = gelu_pk((f32x2){a[0], a[1]}), x1 = gelu_pk((f32x2){a[2], a[3]});
                    const unsigned lo = cvt_pk_bf16(x0.x * up[0], x0.y * up[1]), hi = cvt_pk_bf16(x1.x * up[2], x1.y * up[3]);
                    if (n == 0) { w.x = lo; w.y = hi; } else { w.z = lo; w.w = hi; } }
                if (defer_blk && m == 0 && fr < 2) { float* eg = edge + ((size_t)((1 * 64 + u.pm) * 2 + fr)) * dff + f0; float* eu = edge + ((size_t)((2 * 64 + u.pm) * 2 + fr)) * dff + f0;
                    *(f32x4*)eg = acc[0][0][0][0]; *(f32x4*)(eg + 4) = acc[0][0][0][1]; *(f32x4*)eu = acc[0][1][0][0]; *(f32x4*)(eu + 4) = acc[0][1][0][1]; }
                else *(u32x4*)(ACT + (size_t)row * dff + f0) = w;
                if (ai == 1 && wr == 1 && m == 3 && fr >= 14) { float* el = edge + ((size_t)((0 * 64 + u.pm) * 2 + (fr - 14))) * dff + f0; *(f32x4*)el = acc[1][0][3][0]; *(f32x4*)(el + 4) = acc[1][0][3][1]; }
            }
        }
    }
};

template <class Epi, class Sched, bool ALIGN_EPI = false, bool SP2 = false>
__device__ __forceinline__ void gemm_phase(PG8_LAS unsigned char* lds, const Gemm g, const Sched& S, const Epi& E) {
    int tid_ = threadIdx.x; asm volatile("" : "+v"(tid_));
    const int tid = tid_, wid = __builtin_amdgcn_readfirstlane(tid >> 6), lane = tid & 63, wr = wid >> 2, wc = wid & 3, fr = lane & 15, fq = lane >> 4;
    const int K = g.K, nt = K / BK;
    unsigned voffA[2], voffB[2];
#pragma unroll
    for (int i = 0; i < 2; ++i) { int R, C; stage_rc(tid * 16 + i * 8192, R, C); const int Rb = Epi::PERM ? ((R & ~31) + perm32(R & 31)) : R;
        voffA[i] = (unsigned)(R * g.lda + C) * 2u; voffB[i] = (unsigned)(Rb * g.ldb + C) * 2u; }
    const size_t kstep = (size_t)(BK * 2);
    const size_t hsA = (size_t)HALF * g.lda * 2, hsB = (size_t)HALF * g.ldb * 2;
    const size_t tsA = 2 * hsA, tsB = 2 * hsB;
#define PG8_UA(u) ((const char*)g.A + (size_t)(u).pm * tsA + (g.agrp ? (size_t)((u).pn / g.agrp) * (size_t)K * 2 : (size_t)0))
#define PG8_UB(u) ((const char*)g.Bt + (size_t)(u).pn * tsB)
    const unsigned ldsw = (unsigned)wid * 1024u;
    const int aoff = lds_byte(wr * 64 + fr, fq * 8), boff = lds_byte(wc * 32 + fr, fq * 8);
#define PG8_SA(b, h) (((b) * 2 + (h)) * HTB)
#define PG8_SB(b, h) ((4 + (b) * 2 + (h)) * HTB)
#define PG8_STAGE(bufoff, gbase, voff) do { _Pragma("unroll") for (int _i = 0; _i < 2; ++_i) \
        __builtin_amdgcn_global_load_lds((const unsigned*)((const char*)(gbase) + (voff)[_i]), (PG8_LAS unsigned*)(lds + (bufoff) + ldsw + _i * 8192), 16, 0, 0); } while (0)
#define PG8_LDA(dst, b, h) do { _Pragma("unroll") for (int m = 0; m < 4; ++m) _Pragma("unroll") for (int k = 0; k < 2; ++k) dst[m][k] = *(const PG8_LAS bf16x8*)(lds + PG8_SA(b, h) + aoff + m * 2048 + k * 1024); } while (0)
#define PG8_LDB(dst, b, h) do { _Pragma("unroll") for (int n = 0; n < 2; ++n) _Pragma("unroll") for (int k = 0; k < 2; ++k) dst[n][k] = *(const PG8_LAS bf16x8*)(lds + PG8_SB(b, h) + boff + n * 2048 + k * 1024); } while (0)
#define PG8_MMA(ai, bj, At, Bt) do { __builtin_amdgcn_s_setprio(1); _Pragma("unroll") for (int m = 0; m < 4; ++m) _Pragma("unroll") for (int n = 0; n < 2; ++n) _Pragma("unroll") for (int k = 0; k < 2; ++k) \
        acc[ai][bj][m][n] = __builtin_amdgcn_mfma_f32_16x16x32_bf16(Bt[n][k], At[m][k], acc[ai][bj][m][n], 0, 0, 0); __builtin_amdgcn_s_setprio(0); } while (0)
#define PG8_WAIT_V(n) asm volatile("s_waitcnt vmcnt(" #n ")" ::: "memory")
#define PG8_WAIT_L(n) asm volatile("s_waitcnt lgkmcnt(" #n ")" ::: "memory")
#define PG8_BAR __builtin_amdgcn_s_barrier()
#define PG8_SCHED __builtin_amdgcn_sched_barrier(0)
    Unit cur, nxt; int ui = 0;
    if (!S.next(0, cur)) return;
    f32x4 acc[2][2][4][2];
#pragma unroll
    for (int a = 0; a < 2; ++a)
#pragma unroll
        for (int b = 0; b < 2; ++b)
#pragma unroll
            for (int m = 0; m < 4; ++m)
#pragma unroll
                for (int n = 0; n < 2; ++n) acc[a][b][m][n] = (f32x4){0.f, 0.f, 0.f, 0.f};
    bf16x8 At[4][2], B0[2][2], B1[2][2];
    const char* cA = PG8_UA(cur); const char* cB = PG8_UB(cur);
    S.a_ready(cur);
    if constexpr (SP2) {
        PG8_STAGE(PG8_SB(0, 0), cB, voffB); PG8_STAGE(PG8_SB(0, 1), cB + hsB, voffB); PG8_STAGE(PG8_SA(0, 0), cA, voffA); PG8_STAGE(PG8_SA(0, 1), cA + hsA, voffA);
        if (wr == 1) PG8_BAR;
        PG8_WAIT_V(2); PG8_BAR;
        PG8_STAGE(PG8_SB(1, 0), cB + kstep, voffB); PG8_STAGE(PG8_SA(1, 0), cA + kstep, voffA); PG8_STAGE(PG8_SB(1, 1), cB + hsB + kstep, voffB);
        PG8_WAIT_V(6); PG8_BAR;
    } else {
        PG8_STAGE(PG8_SB(0, 0), cB, voffB); PG8_STAGE(PG8_SA(0, 0), cA, voffA); PG8_STAGE(PG8_SB(0, 1), cB + hsB, voffB); PG8_STAGE(PG8_SA(0, 1), cA + hsA, voffA);
        if (wr == 1) PG8_BAR;
        PG8_WAIT_V(4); PG8_BAR;
        PG8_STAGE(PG8_SB(1, 0), cB + kstep, voffB); PG8_STAGE(PG8_SA(1, 0), cA + kstep, voffA); PG8_STAGE(PG8_SB(1, 1), cB + hsB + kstep, voffB);
        PG8_WAIT_V(6); PG8_BAR;
    }
    for (;;) {
        const bool has_next = S.next(ui + 1, nxt);
        const char* nA = has_next ? PG8_UA(nxt) : cA; const char* nB = has_next ? PG8_UB(nxt) : cB;
        for (int t = 0; t < nt; t += 2) {
            const bool last = (t == nt - 2);
            const char* a1 = cA + (size_t)(t + 1) * kstep;
            const char* a2 = last ? nA : cA + (size_t)(t + 2) * kstep; const char* b2 = last ? nB : cB + (size_t)(t + 2) * kstep;
            const char* a3 = a2 + kstep; const char* b3 = b2 + kstep;
            if (last && has_next) S.a_ready(nxt);
            if constexpr (SP2) {
            PG8_LDB(B0, 0, 0); PG8_LDB(B1, 0, 1); PG8_SCHED; PG8_LDA(At, 0, 0); PG8_STAGE(PG8_SA(1, 1), a1 + hsA, voffA);
            PG8_WAIT_V(8); PG8_WAIT_L(0); PG8_BAR; PG8_MMA(0, 0, At, B0); PG8_MMA(0, 1, At, B1); PG8_BAR; PG8_SCHED;
            PG8_LDA(At, 0, 1); PG8_STAGE(PG8_SB(0, 0), b2, voffB); PG8_STAGE(PG8_SB(0, 1), b2 + hsB, voffB); PG8_STAGE(PG8_SA(0, 0), a2, voffA);
            PG8_WAIT_V(8); PG8_WAIT_L(0); PG8_BAR; PG8_MMA(1, 0, At, B0); PG8_MMA(1, 1, At, B1); PG8_BAR; PG8_SCHED;
            PG8_LDB(B0, 1, 0); PG8_LDB(B1, 1, 1); PG8_SCHED; PG8_LDA(At, 1, 0); PG8_STAGE(PG8_SA(0, 1), a2 + hsA, voffA);
            PG8_WAIT_V(8); PG8_WAIT_L(0); PG8_BAR; PG8_MMA(0, 0, At, B0); PG8_MMA(0, 1, At, B1); PG8_BAR; PG8_SCHED;
            PG8_LDA(At, 1, 1); PG8_STAGE(PG8_SB(1, 0), b3, voffB); PG8_STAGE(PG8_SB(1, 1), b3 + hsB, voffB); PG8_STAGE(PG8_SA(1, 0), a3, voffA);
            PG8_WAIT_V(8); PG8_WAIT_L(0); PG8_BAR; PG8_MMA(1, 0, At, B0); PG8_MMA(1, 1, At, B1); PG8_BAR; PG8_SCHED;
            } else {
            PG8_LDB(B0, 0, 0); PG8_SCHED; PG8_LDA(At, 0, 0); PG8_STAGE(PG8_SA(1, 1), a1 + hsA, voffA);
            PG8_WAIT_L(8); PG8_BAR; PG8_WAIT_L(0); PG8_MMA(0, 0, At, B0); PG8_BAR; PG8_SCHED;
            PG8_LDB(B1, 0, 1); PG8_STAGE(PG8_SB(0, 0), b2, voffB);
            PG8_BAR; PG8_WAIT_L(0); PG8_MMA(0, 1, At, B1); PG8_BAR;
            PG8_LDA(At, 0, 1); PG8_STAGE(PG8_SA(0, 0), a2, voffA);
            PG8_BAR; PG8_WAIT_L(0); PG8_MMA(1, 0, At, B0); PG8_BAR; PG8_SCHED;
            PG8_STAGE(PG8_SB(0, 1), b2 + hsB, voffB);
            PG8_WAIT_V(6); PG8_BAR; PG8_MMA(1, 1, At, B1); PG8_BAR;
            PG8_LDB(B0, 1, 0); PG8_SCHED; PG8_LDA(At, 1, 0); PG8_STAGE(PG8_SA(0, 1), a2 + hsA, voffA);
            PG8_WAIT_L(8); PG8_BAR; PG8_WAIT_L(0); PG8_MMA(0, 0, At, B0); PG8_BAR; PG8_SCHED;
            PG8_LDB(B1, 1, 1); PG8_STAGE(PG8_SB(1, 0), b3, voffB);
            PG8_BAR; PG8_WAIT_L(0); PG8_MMA(0, 1, At, B1); PG8_BAR;
            PG8_LDA(At, 1, 1); PG8_STAGE(PG8_SA(1, 0), a3, voffA);
            PG8_BAR; PG8_WAIT_L(0); PG8_MMA(1, 0, At, B0); PG8_BAR; PG8_SCHED;
            PG8_STAGE(PG8_SB(1, 1), b3 + hsB, voffB);
            PG8_WAIT_V(6); PG8_BAR; PG8_MMA(1, 1, At, B1); PG8_BAR;
            }
        }
        if constexpr (ALIGN_EPI) { if (wr == 0) PG8_BAR; }
        if constexpr (!Epi::AFTER_DRAIN) { E(acc, cur, wr, wc, fr, fq); S.done(cur); }
        if (!has_next) break;
#pragma unroll
        for (int a = 0; a < 2; ++a)
#pragma unroll
            for (int b = 0; b < 2; ++b)
#pragma unroll
                for (int m = 0; m < 4; ++m)
#pragma unroll
                    for (int n = 0; n < 2; ++n) acc[a][b][m][n] = (f32x4){0.f, 0.f, 0.f, 0.f};
        cur = nxt; cA = nA; cB = nB; ++ui;
        if constexpr (ALIGN_EPI) { if (wr == 1) PG8_BAR; }
    }
    PG8_WAIT_V(0);
    if constexpr (!ALIGN_EPI) { if (wr == 0) PG8_BAR; }
    PG8_BAR;
    if constexpr (Epi::AFTER_DRAIN) { E.fused(acc, cur, wr, wc, fr, fq, lds, wid, lane); S.done(cur); }
#undef PG8_UA
#undef PG8_UB
#undef PG8_SA
#undef PG8_SB
#undef PG8_STAGE
#undef PG8_LDA
#undef PG8_LDB
#undef PG8_MMA
#undef PG8_WAIT_V
#undef PG8_WAIT_L
#undef PG8_BAR
#undef PG8_SCHED
}
}

typedef unsigned short bf16;
typedef short bf16x8 __attribute__((ext_vector_type(8)));
typedef float f32x4 __attribute__((ext_vector_type(4)));
typedef unsigned v4u __attribute__((ext_vector_type(4)));
typedef unsigned v2u __attribute__((ext_vector_type(2)));
typedef float f32x2_t __attribute__((ext_vector_type(2)));
#define LAS __attribute__((address_space(3)))
#define DI __device__ __forceinline__
constexpr int D = 2048, BATCH = 4, SEQ = 4096, DEPTH = 4, NH = 16, HD = 128, DFF = 5632;
constexpr int M = BATCH * SEQ;
constexpr int NPROJ = 14336;
constexpr int NIN = 14368;
constexpr int C_Q = 0, C_K = 2048, C_V = 4096, C_Z = 6144, C_P = 8192, C_GA = 10240, C_GB = 12288;
constexpr float EPS = 1e-6f;
constexpr int NWAVES = 8, NTHREADS = 512;

constexpr size_t MiB = 1u << 20;
constexpr size_t WS_CTL = 0;
constexpr size_t WS_WIN = 1 * MiB;
constexpr size_t WS_WOUT = 226 * MiB;
constexpr size_t WS_WUP = 258 * MiB;
constexpr size_t WS_WDN = 434 * MiB;
constexpr size_t WS_WPL = 522 * MiB;
constexpr size_t WS_H = 530 * MiB;

constexpr size_t WS_BA = 594 * MiB;
constexpr size_t WS_BETA = 596 * MiB;
constexpr size_t WS_G = 597 * MiB;
constexpr size_t WS_PROJ = 598 * MiB;
constexpr size_t WS_BIG2 = 1046 * MiB;
constexpr size_t WS_O = 1430 * MiB;
constexpr size_t WS_POOLED = 1558 * MiB;
constexpr size_t WS_YB = 1622 * MiB;
constexpr size_t WS_MIXED = 1686 * MiB;
constexpr size_t WS_EDGE = 1750 * MiB;
constexpr size_t WS_SS = 1760 * MiB;
constexpr size_t SS_BYTES = (size_t)9 * 16384 * 8;
constexpr size_t WS_END = 1762 * MiB;
static_assert(WS_WIN + (size_t)4 * NIN * D * 2 <= WS_WOUT && WS_WUP + (size_t)4 * 2 * DFF * D * 2 <= WS_WDN && WS_WDN + (size_t)4 * D * DFF * 2 <= WS_WPL, "ws map");
static_assert(WS_PROJ + (size_t)M * NPROJ * 2 <= WS_BIG2 && WS_BIG2 + (size_t)3 * M * D * 4 <= WS_O, "ws map");

struct Ctx { const float* in[16]; float* out; unsigned char* ws; };
typedef LAS const unsigned long long* PTab;
DI unsigned long long tab_ld(PTab T, int i) { const unsigned long long v = T[i]; const unsigned lo = __builtin_amdgcn_readfirstlane((unsigned)v), hi = __builtin_amdgcn_readfirstlane((unsigned)(v >> 32)); return ((unsigned long long)hi << 32) | lo; }
#define GAS __attribute__((address_space(1)))
DI const float* inp(PTab T, int i) { return (const float*)(const GAS float*)tab_ld(T, i); }
DI float* outp(PTab T) { return (float*)(GAS float*)tab_ld(T, 16); }
DI unsigned char* wsp(PTab T) { return (unsigned char*)(GAS unsigned char*)tab_ld(T, 17); }
enum { I_X = 0, I_NMW, I_WIN, I_CQW, I_ALOG, I_DTB, I_GNW, I_PW, I_PS, I_WOUT, I_NFW, I_WUP, I_CFW, I_CFB, I_WDN, I_NFIN };

DI int otid() { int t = threadIdx.x; asm volatile("" : "+v"(t)); return t; }
DI float bf2f(bf16 b) { return __uint_as_float(((unsigned)b) << 16); }
DI unsigned f2bf(float f) { unsigned u = __float_as_uint(f); return (u + 0x7fffu + ((u >> 16) & 1u)) >> 16; }
DI unsigned pk2(float lo, float hi) { return f2bf(lo) | (f2bf(hi) << 16); }
DI float lo16(unsigned w) { return __uint_as_float(w << 16); }
DI float hi16(unsigned w) { return __uint_as_float(w & 0xffff0000u); }
DI float wave_sum(float v) {
#pragma unroll
    for (int o = 1; o < 64; o <<= 1) v += __shfl_xor(v, o);
    return v;
}
DI float sigmoidf_(float x) { return 1.0f / (1.0f + expf(-x)); }
DI float siluf_(float x) { return x / (1.0f + expf(-x)); }
DI float softplusf_(float x) { return fmaxf(x, 0.f) + log1pf(expf(-fabsf(x))); }
DI float fexp(float x) { return __builtin_amdgcn_exp2f(x * 1.4426950408889634f); }
DI float frcp(float x) { return __builtin_amdgcn_rcpf(x); }
DI float frsq(float x) { return __builtin_amdgcn_rsqf(x); }
DI float fsigmoid(float x) { return frcp(1.0f + fexp(-x)); }
DI float fsilu(float x) { return x * frcp(1.0f + fexp(-x)); }
DI float gelu_erf(float x) { return 0.5f * x * (1.0f + erff(x * 0.70710678118654752f)); }

DI void transpose_item(const float* W, int ldw, int src_col0, int k0, bf16* WT, int K, int dst_row0, LAS float* scr, int lane, const float* ksc = nullptr) {
#pragma unroll 8
    for (int i = 0; i < 32; ++i) { const int kk = 2 * i + (lane >> 5); scr[kk * 33 + (lane & 31)] = W[(size_t)(k0 + kk) * ldw + src_col0 + (lane & 31)] * (ksc ? ksc[k0 + kk] : 1.0f); }
    asm volatile("s_waitcnt lgkmcnt(0)" ::: "memory");
    const int c = lane & 7;
#pragma unroll
    for (int j = 0; j < 4; ++j) { const int n = (lane >> 3) + 8 * j; const LAS float* s = scr + (8 * c) * 33 + n;
        v4u o; o.x = pk2(s[0 * 33], s[1 * 33]); o.y = pk2(s[2 * 33], s[3 * 33]); o.z = pk2(s[4 * 33], s[5 * 33]); o.w = pk2(s[6 * 33], s[7 * 33]);
        *(v4u*)(WT + (size_t)(dst_row0 + n) * K + k0 + 8 * c) = o; }
    asm volatile("s_waitcnt lgkmcnt(0)" ::: "memory");
}
constexpr int IT_IN = (D / 64) * (NIN / 32), IT_OUT = (D / 64) * (D / 32), IT_UP = (D / 64) * (2 * DFF / 32), IT_DN = (DFF / 64) * (D / 32), IT_PL = 4 * (512 / 64) * (512 / 32);
constexpr int IT_LAYER = IT_IN + IT_OUT + IT_UP + IT_DN + IT_PL;
DI void ph_convert(PTab T, LAS unsigned char* lds) {
    const int tid = otid(), lane = tid & 63, wave = __builtin_amdgcn_readfirstlane(tid >> 6), gw = blockIdx.x * NWAVES + wave, ngw = gridDim.x * NWAVES; (void)lane; (void)gw; (void)ngw;
    unsigned char* const ws = wsp(T); (void)ws;
    LAS float* scr = (LAS float*)(lds + wave * 16384);
    for (int it = gw; it < DEPTH * IT_LAYER; it += ngw) {
        const int l = it / IT_LAYER; int r = it % IT_LAYER;
        if (r < IT_IN) { const int nblk = NIN / 32, kb = r / nblk, nb = r % nblk; const int n0 = 32 * nb;
            const int sc = n0 < 8192 ? n0 : (n0 < NPROJ ? n0 + 32 : 8192 + (n0 - NPROJ));
            transpose_item(inp(T, I_WIN) + (size_t)l * D * NIN, NIN, sc, 64 * kb, (bf16*)(ws + WS_WIN) + (size_t)l * NIN * D, D, n0, scr, lane, inp(T, I_NMW) + l * D); continue; }
        r -= IT_IN;
        if (r < IT_OUT) { const int nblk = D / 32, kb = r / nblk, nb = r % nblk;
            transpose_item(inp(T, I_WOUT) + (size_t)l * D * D, D, 32 * nb, 64 * kb, (bf16*)(ws + WS_WOUT) + (size_t)l * D * D, D, 32 * nb, scr, lane); continue; }
        r -= IT_OUT;
        if (r < IT_UP) { const int nblk = 2 * DFF / 32, kb = r / nblk, nb = r % nblk;
            const int n0 = 32 * nb, sc = ((n0 >> 7) & 1) * DFF + 128 * (n0 >> 8) + (n0 & 127);
            transpose_item(inp(T, I_WUP) + (size_t)l * D * 2 * DFF, 2 * DFF, sc, 64 * kb, (bf16*)(ws + WS_WUP) + (size_t)l * 2 * DFF * D, D, n0, scr, lane, inp(T, I_NFW) + l * D); continue; }
        r -= IT_UP;
        if (r < IT_DN) { const int nblk = D / 32, kb = r / nblk, nb = r % nblk;
            transpose_item(inp(T, I_WDN) + (size_t)l * DFF * D, D, 32 * nb, 64 * kb, (bf16*)(ws + WS_WDN) + (size_t)l * D * DFF, DFF, 32 * nb, scr, lane); continue; }
        r -= IT_DN;
        { const int g = r / 128, rr = r % 128, kb = rr / 16, nb = rr % 16;
            transpose_item(inp(T, I_PW) + (size_t)(l * 4 + g) * 512 * 512, 512, 32 * nb, 64 * kb, (bf16*)(ws + WS_WPL) + (size_t)l * D * 512, 512, g * 512 + 32 * nb, scr, lane); }
    }
    { const float* x = inp(T, I_X); bf16* xb = (bf16*)(ws + WS_H); unsigned long long* ss = (unsigned long long*)(ws + WS_SS);
      for (int m = gw; m < M; m += ngw) { const f32x4* xr = (const f32x4*)(x + (size_t)m * D) + lane; f32x4 v[8]; float s = 0.f;
#pragma unroll
          for (int j = 0; j < 8; ++j) { v[j] = xr[64 * j]; s += (v[j].x * v[j].x + v[j].y * v[j].y) + (v[j].z * v[j].z + v[j].w * v[j].w); }
          s = wave_sum(s); v2u* o = (v2u*)(xb + (size_t)m * D) + lane;
#pragma unroll
          for (int j = 0; j < 8; ++j) { v2u p; p.x = pk2(v[j].x, v[j].y); p.y = pk2(v[j].z, v[j].w); o[64 * j] = p; }
          if (lane == 0) ss[m] = (unsigned long long)(s * 1048576.0f + 0.5f); } }
}

DI void ph_rmsnorm_bf16(const float* x, const float* w, bf16* out) {
    const int tid = otid(), lane = tid & 63, wave = __builtin_amdgcn_readfirstlane(tid >> 6), gw = blockIdx.x * NWAVES + wave, ngw = gridDim.x * NWAVES;
    for (int m = gw; m < M; m += ngw) {
        const f32x4* xr = (const f32x4*)(x + (size_t)m * D) + lane; f32x4 v[8]; float s = 0.f;
#pragma unroll
        for (int j = 0; j < 8; ++j) { v[j] = xr[64 * j]; s += (v[j].x * v[j].x + v[j].y * v[j].y) + (v[j].z * v[j].z + v[j].w * v[j].w); }
        const float rstd = 1.0f / sqrtf(wave_sum(s) * (1.0f / D) + EPS);
        v2u* o = (v2u*)(out + (size_t)m * D) + lane;
#pragma unroll
        for (int j = 0; j < 8; ++j) { const f32x4 ww = ((const f32x4*)w)[lane + 64 * j]; v2u p; p.x = pk2(v[j].x * rstd * ww.x, v[j].y * rstd * ww.y); p.y = pk2(v[j].z * rstd * ww.z, v[j].w * rstd * ww.w); o[64 * j] = p; }
    }
}
DI void ph_final_norm(float* x, const float* w, const unsigned long long* ss) {
    const int tid = otid();
    for (size_t e = (size_t)blockIdx.x * NTHREADS + tid; e < (size_t)M * D / 4; e += (size_t)gridDim.x * NTHREADS) {
        const int m = (int)(e >> 9), c4 = (int)(e & 511); const float rs = frsq(pg8::ss_val(ss[m]) * (1.0f / D) + EPS);
        const f32x4 v = ((const f32x4*)x)[e], ww = ((const f32x4*)w)[c4]; ((f32x4*)x)[e] = (f32x4){v.x * rs * ww.x, v.y * rs * ww.y, v.z * rs * ww.z, v.w * rs * ww.w}; }
}
DI void ph_ba(PTab T, int l, const unsigned long long* ss) {
    const int tid = otid(), lane = tid & 63, wave = __builtin_amdgcn_readfirstlane(tid >> 6), gw = blockIdx.x * NWAVES + wave, ngw = gridDim.x * NWAVES; (void)lane; (void)gw; (void)ngw;
    unsigned char* const ws = wsp(T); (void)ws;
    const bf16* H = (const bf16*)(ws + WS_H); const bf16* Wt = (const bf16*)(ws + WS_WIN) + ((size_t)l * NIN + NPROJ) * D; float* BA = (float*)(ws + WS_BA);
    const int r = lane & 15, g = lane >> 4;
    for (int wt = gw; wt < M / 16; wt += ngw) {
        const bf16* ap = H + (size_t)(wt * 16 + r) * D + 8 * g; const bf16* b0p = Wt + (size_t)r * D + 8 * g; const bf16* b1p = Wt + (size_t)(16 + r) * D + 8 * g;
        f32x4 acc0 = {0.f, 0.f, 0.f, 0.f}, acc1 = {0.f, 0.f, 0.f, 0.f};
#pragma unroll 4
        for (int k0 = 0; k0 < D; k0 += 32) { const bf16x8 a = *(const bf16x8*)(ap + k0), b0 = *(const bf16x8*)(b0p + k0), b1 = *(const bf16x8*)(b1p + k0);
            acc0 = __builtin_amdgcn_mfma_f32_16x16x32_bf16(a, b0, acc0, 0, 0, 0); acc1 = __builtin_amdgcn_mfma_f32_16x16x32_bf16(a, b1, acc1, 0, 0, 0); }
#pragma unroll
        for (int j = 0; j < 4; ++j) { const int row = wt * 16 + 4 * g + j; const float rs = frsq(pg8::ss_val(ss[row]) * (1.0f / D) + EPS); float* o = BA + (size_t)row * 32; o[r] = acc0[j] * rs; o[16 + r] = acc1[j] * rs; }
    }
}

DI void ph_qkvconv_naive(PTab T, int l) {
    const int tid = otid(), lane = tid & 63, wave = __builtin_amdgcn_readfirstlane(tid >> 6), gw = blockIdx.x * NWAVES + wave, ngw = gridDim.x * NWAVES; (void)lane; (void)gw; (void)ngw;
    unsigned char* const ws = wsp(T); (void)ws;
    const bf16* P = (const bf16*)(ws + WS_PROJ); const float* cw = inp(T, I_CQW) + (size_t)l * 4 * 3 * D;
    float* QN = (float*)(ws + WS_BIG2); float* KN = QN + (size_t)M * D; float* VN = KN + (size_t)M * D;
    for (int task = gw; task < M * NH; task += ngw) {
        const int m = task >> 4, hh = task & 15, t = m & (SEQ - 1);
#pragma unroll
        for (int sec = 0; sec < 3; ++sec) {
            const int col = sec * D + hh * HD + 2 * lane; float a0 = 0.f, a1 = 0.f;
#pragma unroll
            for (int j = 0; j < 4; ++j) { const int tt = t - 3 + j; if (tt >= 0) { const unsigned w = *(const unsigned*)(P + (size_t)(m - 3 + j) * NPROJ + col);
                    a0 += cw[(size_t)j * 3 * D + col] * lo16(w); a1 += cw[(size_t)j * 3 * D + col + 1] * hi16(w); } }
            a0 = siluf_(a0); a1 = siluf_(a1);
            float* dst = (sec == 0 ? QN : sec == 1 ? KN : VN) + (size_t)m * D + hh * HD + 2 * lane;
            if (sec < 2) { const float ss = wave_sum(a0 * a0 + a1 * a1); float sc = 1.0f / sqrtf(ss + EPS); if (sec == 0) sc *= 0.08838834764831845f; a0 *= sc; a1 *= sc; }
            dst[0] = a0; dst[1] = a1;
        }
        if (lane == 0) { const float* ba = (const float*)(ws + WS_BA) + (size_t)m * 32;
            ((float*)(ws + WS_BETA))[(size_t)m * 16 + hh] = sigmoidf_(ba[hh]);
            ((float*)(ws + WS_G))[(size_t)m * 16 + hh] = -expf(inp(T, I_ALOG)[l * NH + hh]) * softplusf_(ba[16 + hh] + inp(T, I_DTB)[l * NH + hh]); }
    }
}
DI void ph_gdn_naive(PTab T, LAS unsigned char* lds) {
    const int tid = otid(), unit0 = blockIdx.x, nunits_stride = gridDim.x;
    unsigned char* const ws = wsp(T);
    const float* QN = (const float*)(ws + WS_BIG2); const float* KN = QN + (size_t)M * D; const float* VN = KN + (size_t)M * D;
    const float* BETA = (const float*)(ws + WS_BETA); const float* G = (const float*)(ws + WS_G); float* O = (float*)(ws + WS_O);
    constexpr int TB = 16;
    LAS float* kl = (LAS float*)lds;
    LAS float* ql = kl + TB * 144;
    LAS float* vl = ql + TB * 144;
    LAS float* bl = vl + TB * 128;
    const int j = tid >> 2, p = tid & 3;
    for (int u = unit0; u < BATCH * NH; u += nunits_stride) {
        const int b = u >> 4, hh = u & 15; float S[32];
#pragma unroll
        for (int i = 0; i < 32; ++i) S[i] = 0.f;
        for (int t0 = 0; t0 < SEQ; t0 += TB) {
            __syncthreads();
            for (int e = tid; e < TB * 128; e += NTHREADS) { const int tt = e >> 7, cc = e & 127; const size_t gi = (size_t)(b * SEQ + t0 + tt) * D + hh * HD + cc;
                kl[tt * 144 + (cc >> 5) * 36 + (cc & 31)] = KN[gi]; ql[tt * 144 + (cc >> 5) * 36 + (cc & 31)] = QN[gi]; vl[tt * 128 + cc] = VN[gi]; }
            if (tid < TB) { const size_t gi = (size_t)(b * SEQ + t0 + tid) * 16 + hh; bl[tid * 2] = BETA[gi]; bl[tid * 2 + 1] = expf(G[gi]); }
            __syncthreads();
            for (int tt = 0; tt < TB; ++tt) {
                const float beta = bl[tt * 2], a = bl[tt * 2 + 1]; const LAS float* kp = kl + tt * 144 + p * 36; const LAS float* qp = ql + tt * 144 + p * 36;
                float kk[32]; float d = 0.f;
#pragma unroll
                for (int i = 0; i < 32; ++i) { kk[i] = kp[i]; d += S[i] * kk[i]; }
                d += __shfl_xor(d, 1); d += __shfl_xor(d, 2);
                const float vn = beta * (vl[tt * 128 + j] - a * d); float oo = 0.f;
#pragma unroll
                for (int i = 0; i < 32; ++i) { S[i] = a * S[i] + kk[i] * vn; oo += S[i] * qp[i]; }
                oo += __shfl_xor(oo, 1); oo += __shfl_xor(oo, 2);
                if (p == 0) O[(size_t)(b * SEQ + t0 + tt) * D + hh * HD + j] = oo;
            }
        }
    }
}
template <int WIN> DI void pooled_run(const bf16* P, bf16* PO, int m0, int col) {
    float r0[WIN], r1[WIN], s0 = 0.f, s1 = 0.f; const int t0 = m0 & (SEQ - 1);
#pragma unroll
    for (int j = 0; j < WIN; ++j) { const unsigned w = (t0 - WIN + j >= 0) ? *(const unsigned*)(P + (size_t)(m0 - WIN + j) * NPROJ + col) : 0u; r0[j] = lo16(w); r1[j] = hi16(w); s0 += r0[j]; s1 += r1[j]; }
    for (int base = 0; base < 128; base += WIN) {
        unsigned w[WIN];
#pragma unroll
        for (int j = 0; j < WIN; ++j) w[j] = *(const unsigned*)(P + (size_t)(m0 + base + j) * NPROJ + col);
#pragma unroll
        for (int j = 0; j < WIN; ++j) { const float x0 = lo16(w[j]), x1 = hi16(w[j]); s0 += x0 - r0[j]; s1 += x1 - r1[j]; r0[j] = x0; r1[j] = x1;
            const int t = t0 + base + j; const float inv = frcp((float)((t + 1) < WIN ? (t + 1) : WIN));
            *(unsigned*)(PO + (size_t)(m0 + base + j) * D + col) = pk2(s0 * inv - x0, s1 * inv - x1); }
    }
}
DI void ph_pooled(PTab T) {
    unsigned char* const ws = wsp(T); const bf16* P = (const bf16*)(ws + WS_PROJ) + C_P; bf16* PO = (bf16*)(ws + WS_POOLED);
    const int tid = otid();
    for (int e = blockIdx.x * NTHREADS + tid; e < (M / 128) * (D / 2); e += gridDim.x * NTHREADS) {
        const int c2 = e & 1023, rb = e >> 10, col = 2 * c2, gi = c2 >> 8, m0 = rb * 128;
        if (gi == 0) pooled_run<2>(P, PO, m0, col); else if (gi == 1) pooled_run<4>(P, PO, m0, col); else if (gi == 2) pooled_run<8>(P, PO, m0, col); else pooled_run<16>(P, PO, m0, col);
    }
}
DI void ph_mix(PTab T, int l) {
    const int tid = otid(), lane = tid & 63, wave = __builtin_amdgcn_readfirstlane(tid >> 6), gw = blockIdx.x * NWAVES + wave, ngw = gridDim.x * NWAVES;
    unsigned char* const ws = wsp(T);
    const bf16* P = (const bf16*)(ws + WS_PROJ); const float* O = (const float*)(ws + WS_O); const bf16* YB = (const bf16*)(ws + WS_YB); bf16* MX = (bf16*)(ws + WS_MIXED);
    const float gn0 = inp(T, I_GNW)[l * HD + 2 * lane], gn1 = inp(T, I_GNW)[l * HD + 2 * lane + 1]; const float* ps = inp(T, I_PS) + l * D;
    for (int m = gw; m < M; m += ngw) {
#pragma unroll
        for (int half = 0; half < 2; ++half) {
            f32x2_t o[8]; unsigned z[8], ga[8], gb[8], yb[8]; f32x2_t sc[8];
#pragma unroll
            for (int i = 0; i < 8; ++i) { const int col = (half * 8 + i) * HD + 2 * lane; o[i] = *(const f32x2_t*)(O + (size_t)m * D + col); z[i] = *(const unsigned*)(P + (size_t)m * NPROJ + C_Z + col);
                ga[i] = *(const unsigned*)(P + (size_t)m * NPROJ + C_GA + col); gb[i] = *(const unsigned*)(P + (size_t)m * NPROJ + C_GB + col); yb[i] = *(const unsigned*)(YB + (size_t)m * D + col); sc[i] = *(const f32x2_t*)(ps + col); }
#pragma unroll
            for (int i = 0; i < 8; ++i) { const int col = (half * 8 + i) * HD + 2 * lane;
                const float rstd = frsq(wave_sum(o[i].x * o[i].x + o[i].y * o[i].y) * (1.0f / HD) + EPS);
                const float ya0 = o[i].x * rstd * gn0 * fsilu(lo16(z[i])), ya1 = o[i].y * rstd * gn1 * fsilu(hi16(z[i]));
                const float r0 = fsigmoid(lo16(ga[i])) * ya0 + fsigmoid(lo16(gb[i])) * lo16(yb[i]) * sc[i].x, r1 = fsigmoid(hi16(ga[i])) * ya1 + fsigmoid(hi16(gb[i])) * hi16(yb[i]) * sc[i].y;
                *(unsigned*)(MX + (size_t)m * D + col) = pk2(r0, r1); }
        }
    }
}
DI void ph_glu_fix(PTab T, int l) {
    unsigned char* const ws = wsp(T); const float* edge = (const float*)(ws + WS_EDGE); bf16* ACT = (bf16*)(ws + WS_BIG2);
    const float* cw = inp(T, I_CFW) + (size_t)l * 3 * DFF; const float* cb = inp(T, I_CFB) + (size_t)l * DFF;
    const int tid = otid();
    for (int e = blockIdx.x * NTHREADS + tid; e < 64 * DFF; e += gridDim.x * NTHREADS) {
        const int pm = e / DFF, f = e % DFF; if ((pm & 15) == 0) continue;
        const float gm2 = edge[((size_t)((0 * 64 + pm - 1) * 2 + 0)) * DFF + f], gm1 = edge[((size_t)((0 * 64 + pm - 1) * 2 + 1)) * DFF + f];
        const float g0 = edge[((size_t)((1 * 64 + pm) * 2 + 0)) * DFF + f], g1 = edge[((size_t)((1 * 64 + pm) * 2 + 1)) * DFF + f];
        const float u0 = edge[((size_t)((2 * 64 + pm) * 2 + 0)) * DFF + f], u1 = edge[((size_t)((2 * 64 + pm) * 2 + 1)) * DFF + f];
        const float w0 = cw[f], w1 = cw[DFF + f], w2 = cw[2 * DFF + f], bb = cb[f];
        ACT[(size_t)(pm * 256) * DFF + f] = (bf16)f2bf(gelu_erf(w0 * gm2 + w1 * gm1 + w2 * g0 + bb) * u0);
        ACT[(size_t)(pm * 256 + 1) * DFF + f] = (bf16)f2bf(gelu_erf(w0 * gm1 + w1 * g0 + w2 * g1 + bb) * u1);
    }
}
typedef float f32x16 __attribute__((ext_vector_type(16)));
typedef __bf16 bf16x2_t __attribute__((ext_vector_type(2)));
DI unsigned cvtpk(float lo, float hi) { const f32x2_t v = {lo, hi}; const bf16x2_t b = __builtin_convertvector(v, bf16x2_t); return __builtin_bit_cast(unsigned, b); }
DI bf16x8 mk8(float a0, float a1, float a2, float a3, float a4, float a5, float a6, float a7) { v4u p; p.x = cvtpk(a0, a1); p.y = cvtpk(a2, a3); p.z = cvtpk(a4, a5); p.w = cvtpk(a6, a7); return __builtin_bit_cast(bf16x8, p); }
#define MFMA32(a, b, c) __builtin_amdgcn_mfma_f32_32x32x16_bf16((a), (b), (c), 0, 0, 0)
#define PACK_STEP(x, s) mk8((x)[8 * (s)], (x)[8 * (s) + 1], (x)[8 * (s) + 2], (x)[8 * (s) + 3], (x)[8 * (s) + 4], (x)[8 * (s) + 5], (x)[8 * (s) + 6], (x)[8 * (s) + 7])
DI f32x16 zero16() { f32x16 z; for (int i = 0; i < 16; ++i) z[i] = 0.f; return z; }
DI bf16x8 frag_row(const LAS float* p) { const f32x4 a = *(const LAS f32x4*)p, b = *(const LAS f32x4*)(p + 4); return mk8(a.x, a.y, a.z, a.w, b.x, b.y, b.z, b.w); }
DI bf16x8 frag_row_s(const LAS float* p, const LAS float* f) { const f32x4 a = *(const LAS f32x4*)p, b = *(const LAS f32x4*)(p + 4), fa = *(const LAS f32x4*)f, fb = *(const LAS f32x4*)(f + 4);
    return mk8(a.x * fa.x, a.y * fa.y, a.z * fa.z, a.w * fa.w, b.x * fb.x, b.y * fb.y, b.z * fb.z, b.w * fb.w); }
DI bf16x8 frag_col(const LAS float* p, int stride) { return mk8(p[0], p[stride], p[2 * stride], p[3 * stride], p[4 * stride], p[5 * stride], p[6 * stride], p[7 * stride]); }

constexpr int OFF_WT = 0, OFF_QDT = 16384, OFF_ATT = 32768, OFF_KE = 38912, OFF_U = 55296, SHARED_BYTES = 55296, UNIT_BYTES = 88064;
constexpr int NUNITS = BATCH * NH * (SEQ / 64);
static_assert((size_t)NUNITS * UNIT_BYTES <= 384 * MiB, "gdn image fits its region");
constexpr int QS = 132, LS = 68;
constexpr int L_QN = 0, L_KN = 64 * QS * 4, L_VN = 2 * 64 * QS * 4, L_LM = 3 * 64 * QS * 4, L_TM = L_LM + 64 * LS * 4, L_VEC = L_TM + 64 * LS * 4;
static_assert(L_VEC + 5 * 256 <= 143360, "chunk-local LDS map");

DI void gdn_chunk_unit(PTab T, int l, LAS unsigned char* lds, int unit) {
    const int tid = otid(), lane = tid & 63, w = __builtin_amdgcn_readfirstlane(tid >> 6), c = lane & 31, h = lane >> 5;
    unsigned char* const ws = wsp(T);
    const int bh = unit >> 6, n = unit & 63, b = bh >> 4, hh = bh & 15, m0 = b * SEQ + n * 64;
    LAS float* QN = (LAS float*)(lds + L_QN); LAS float* KN = (LAS float*)(lds + L_KN); LAS float* VN = (LAS float*)(lds + L_VN);
    LAS float* LM = (LAS float*)(lds + L_LM); LAS float* TM = (LAS float*)(lds + L_TM);
    LAS float* VG = (LAS float*)(lds + L_VEC); LAS float* VBETA = VG + 64; LAS float* VEG = VG + 128; LAS float* VEKE = VG + 192; LAS float* VBEG = VG + 256;
    unsigned char* const ub = ws + WS_BIG2 + (size_t)unit * UNIT_BYTES;
    {
        const bf16* P = (const bf16*)(ws + WS_PROJ) + (size_t)hh * HD + 2 * lane; const float* cw = inp(T, I_CQW) + (size_t)l * 4 * 3 * D + hh * HD + 2 * lane;
#pragma unroll
        for (int sec = 0; sec < 3; ++sec) {
            unsigned raw[11];
#pragma unroll
            for (int i = 0; i < 11; ++i) { const int rr = 8 * w - 3 + i; raw[i] = (n * 64 + rr >= 0) ? *(const unsigned*)(P + (size_t)(m0 + rr) * NPROJ + sec * D) : 0u; }
            float w0[4], w1[4];
#pragma unroll
            for (int j = 0; j < 4; ++j) { w0[j] = cw[(size_t)j * 3 * D + sec * D]; w1[j] = cw[(size_t)j * 3 * D + sec * D + 1]; }
            LAS float* dst = (sec == 0 ? QN : sec == 1 ? KN : VN) + 2 * lane;
#pragma unroll
            for (int r = 0; r < 8; ++r) {
                float a0 = 0.f, a1 = 0.f;
#pragma unroll
                for (int j = 0; j < 4; ++j) { a0 += w0[j] * lo16(raw[r + j]); a1 += w1[j] * hi16(raw[r + j]); }
                a0 = fsilu(a0); a1 = fsilu(a1);
                if (sec < 2) { const float ss = wave_sum(a0 * a0 + a1 * a1); float sc = frsq(ss + EPS); if (sec == 0) sc *= 0.08838834764831845f; a0 *= sc; a1 *= sc; }
                *(LAS f32x2_t*)(dst + (8 * w + r) * QS) = (f32x2_t){a0, a1};
            }
        }
        if (w == 0) {
            const float* ba = (const float*)(ws + WS_BA) + (size_t)(m0 + lane) * 32;
            const float beta = sigmoidf_(ba[hh]); const float g = -expf(inp(T, I_ALOG)[l * NH + hh]) * softplusf_(ba[16 + hh] + inp(T, I_DTB)[l * NH + hh]);
            float G = g;
#pragma unroll
            for (int o = 1; o < 64; o <<= 1) { const float t = __shfl_up(G, o); if (lane >= o) G += t; }
            const float G63 = __shfl(G, 63); const float eg = expf(G);
            VG[lane] = G; VBETA[lane] = beta; VEG[lane] = eg; VEKE[lane] = expf(G63 - G); VBEG[lane] = beta * eg;
            if (lane == 63) ((float*)(ws + WS_BETA))[unit] = eg;
        }
    }
    __syncthreads();
    if (w < 3) {
        const int ti = (w == 0) ? 0 : 1, tj = (w == 2) ? 1 : 0;
        f32x16 acc = zero16();
#pragma unroll
        for (int ks = 0; ks < 8; ++ks) acc = MFMA32(frag_row(KN + (32 * ti + c) * QS + 16 * ks + 8 * h), frag_row(KN + (32 * tj + c) * QS + 16 * ks + 8 * h), acc);
        const int jp = 32 * tj + c; const float Gj = VG[jp];
#pragma unroll
        for (int g4 = 0; g4 < 4; ++g4) { const int ip0 = 32 * ti + 8 * g4 + 4 * h; const f32x4 Gi = *(const LAS f32x4*)(VG + ip0), Bi = *(const LAS f32x4*)(VBETA + ip0);
#pragma unroll
            for (int q = 0; q < 4; ++q) { const int ip = ip0 + q; LM[ip * LS + jp] = (ip > jp) ? Bi[q] * acc[4 * g4 + q] * fexp(Gi[q] - Gj) : 0.f; } }
    }
    __syncthreads();
    if (w == 0) {
        const int blk = h; const LAS float* Lp = LM + (32 * blk) * LS + 32 * blk; float t[32];
#pragma unroll
        for (int ii = 0; ii < 32; ++ii) {
            float a = (c == ii) ? 1.f : 0.f;
#pragma unroll
            for (int j4 = 0; j4 < (ii + 3) / 4; ++j4) { const f32x4 lv = *(const LAS f32x4*)(Lp + ii * LS + 4 * j4);
#pragma unroll
                for (int q = 0; q < 4; ++q) if (4 * j4 + q < ii) a -= lv[q] * t[4 * j4 + q]; }
            t[ii] = a;
        }
#pragma unroll
        for (int ii = 0; ii < 32; ++ii) TM[(32 * blk + ii) * LS + 32 * blk + c] = t[ii];
        asm volatile("s_waitcnt lgkmcnt(0)" ::: "memory");
        f32x16 x = zero16();
#pragma unroll
        for (int ks = 0; ks < 2; ++ks) x = MFMA32(frag_row(LM + (32 + c) * LS + 16 * ks + 8 * h), frag_col(TM + (16 * ks + 8 * h) * LS + c, LS), x);
        f32x16 y = zero16();
#pragma unroll
        for (int s = 0; s < 2; ++s) { const LAS float* tp = TM + (32 + c) * LS + 32 + 16 * s + 4 * h; const f32x4 a = *(const LAS f32x4*)tp, bq = *(const LAS f32x4*)(tp + 8);
            y = MFMA32(mk8(a.x, a.y, a.z, a.w, bq.x, bq.y, bq.z, bq.w), PACK_STEP(x, s), y); }
#pragma unroll
        for (int g4 = 0; g4 < 4; ++g4)
#pragma unroll
            for (int q = 0; q < 4; ++q) TM[(32 + 8 * g4 + 4 * h + q) * LS + c] = -y[4 * g4 + q];
    } else if (w < 4) {
        const int tj = (w == 3) ? 1 : 0, ti = (w == 1) ? 0 : 1, t3 = w - 1;
        f32x16 acc = zero16();
#pragma unroll
        for (int ks = 0; ks < 8; ++ks) acc = MFMA32(frag_row(KN + (32 * tj + c) * QS + 16 * ks + 8 * h), frag_row(QN + (32 * ti + c) * QS + 16 * ks + 8 * h), acc);
        const int ip = 32 * ti + c; const float Gi = VG[ip];
#pragma unroll
        for (int g4 = 0; g4 < 4; ++g4) { const int jp0 = 32 * tj + 8 * g4 + 4 * h; const f32x4 Gj = *(const LAS f32x4*)(VG + jp0);
#pragma unroll
            for (int q = 0; q < 4; ++q) acc[4 * g4 + q] = (ip >= jp0 + q) ? acc[4 * g4 + q] * fexp(Gi - Gj[q]) : 0.f; }
        *(bf16x8*)(ub + OFF_ATT + (t3 * 2 + 0) * 1024 + lane * 16) = PACK_STEP(acc, 0);
        *(bf16x8*)(ub + OFF_ATT + (t3 * 2 + 1) * 1024 + lane * 16) = PACK_STEP(acc, 1);
    } else if (w < 6) {
        const int ti = w - 4; const float e = VEG[32 * ti + c];
#pragma unroll
        for (int d = 0; d < 4; ++d)
#pragma unroll
            for (int s = 0; s < 2; ++s) { const LAS float* p = QN + (32 * ti + c) * QS + 32 * d + 16 * s + 4 * h; const f32x4 a = *(const LAS f32x4*)p, bq = *(const LAS f32x4*)(p + 8);
                *(bf16x8*)(ub + OFF_QDT + ((d * 2 + ti) * 2 + s) * 1024 + lane * 16) = mk8(a.x * e, a.y * e, a.z * e, a.w * e, bq.x * e, bq.y * e, bq.z * e, bq.w * e); }
    } else {
        const int tj = w - 6;
#pragma unroll
        for (int s = 0; s < 2; ++s) { const int tok0 = 32 * tj + 16 * s + 4 * h; const f32x4 fa = *(const LAS f32x4*)(VEKE + tok0), fb = *(const LAS f32x4*)(VEKE + tok0 + 8);
#pragma unroll
            for (int d = 0; d < 4; ++d) { const LAS float* p = KN + tok0 * QS + 32 * d + c;
                *(bf16x8*)(ub + OFF_KE + ((d * 2 + tj) * 2 + s) * 1024 + lane * 16) = mk8(p[0] * fa.x, p[QS] * fa.y, p[2 * QS] * fa.z, p[3 * QS] * fa.w, p[8 * QS] * fb.x, p[9 * QS] * fb.y, p[10 * QS] * fb.z, p[11 * QS] * fb.w); } }
    }
    __syncthreads();
    {
        const int d = w >> 1, ti = w & 1; f32x16 acc = zero16();
#pragma unroll
        for (int ks = 0; ks < 4; ++ks) if (ks < 2 || ti == 1)
            acc = MFMA32(frag_col(KN + (16 * ks + 8 * h) * QS + 32 * d + c, QS), frag_row_s(TM + (32 * ti + c) * LS + 16 * ks + 8 * h, VBEG + 16 * ks + 8 * h), acc);
#pragma unroll
        for (int i = 0; i < 16; ++i) acc[i] = -acc[i];
        *(bf16x8*)(ub + OFF_WT + ((d * 2 + ti) * 2 + 0) * 1024 + lane * 16) = PACK_STEP(acc, 0);
        *(bf16x8*)(ub + OFF_WT + ((d * 2 + ti) * 2 + 1) * 1024 + lane * 16) = PACK_STEP(acc, 1);
    }
    {
        const int vt = w >> 1, ti = 1 - (w & 1); f32x16 acc = zero16();
#pragma unroll
        for (int ks = 0; ks < 4; ++ks) if (ks < 2 || ti == 1)
            acc = MFMA32(frag_row_s(TM + (32 * ti + c) * LS + 16 * ks + 8 * h, VBETA + 16 * ks + 8 * h), frag_col(VN + (16 * ks + 8 * h) * QS + 32 * vt + c, QS), acc);
        f32x4* up = (f32x4*)(ub + OFF_U + (ti * 4 + vt) * 4096 + lane * 64);
#pragma unroll
        for (int g4 = 0; g4 < 4; ++g4) up[g4] = (f32x4){acc[4 * g4], acc[4 * g4 + 1], acc[4 * g4 + 2], acc[4 * g4 + 3]};
    }
    __syncthreads();
}
DI void ph_gdn_chunks(PTab T, int l, LAS unsigned char* lds) {
    for (int unit = blockIdx.x; unit < NUNITS; unit += gridDim.x) gdn_chunk_unit(T, l, lds, unit);
}

#define SCAN_BAR() do { asm volatile("" ::: "memory"); __builtin_amdgcn_s_barrier(); asm volatile("" ::: "memory"); } while (0)
DI void ph_gdn_scan(PTab T, LAS unsigned char* lds, int bh) {
    const int tid = otid(), lane = tid & 63, w = __builtin_amdgcn_readfirstlane(tid >> 6), c = lane & 31, h = lane >> 5;
    unsigned char* const ws = wsp(T);
    const unsigned char* const gb = ws + WS_BIG2 + (size_t)bh * 64 * UNIT_BYTES;
    if (w >= 4) {
        for (int f = w - 4; f < 54; f += 4) __builtin_amdgcn_global_load_lds((const unsigned*)(gb + f * 1024 + lane * 16), (LAS unsigned*)(lds + f * 1024), 16, 0, 0);
        asm volatile("s_waitcnt vmcnt(0)" ::: "memory"); SCAN_BAR();
        for (int n = 0; n < 64; ++n) {
            if (n + 1 < 64) { const unsigned char* src = gb + (size_t)(n + 1) * UNIT_BYTES; LAS unsigned char* dst = lds + ((n + 1) & 1) * SHARED_BYTES;
                for (int f = w - 4; f < 54; f += 4) __builtin_amdgcn_global_load_lds((const unsigned*)(src + f * 1024 + lane * 16), (LAS unsigned*)(dst + f * 1024), 16, 0, 0); }
            asm volatile("s_waitcnt vmcnt(0)" ::: "memory"); SCAN_BAR();
        }
        return;
    }
    const float decv = ((const float*)(ws + WS_BETA))[bh * 64 + lane];
    const int b = bh >> 4, hh = bh & 15;
    float* const Ob = (float*)(ws + WS_O) + (size_t)b * SEQ * D + hh * HD + 32 * w;
    const int loff = 4 * h * D + c;
    const unsigned char* const ubase = gb + OFF_U + w * 4096 + lane * 64;
    f32x16 S[4], P0, P1;
#pragma unroll
    for (int d = 0; d < 4; ++d) S[d] = zero16();
    { const f32x4* up = (const f32x4*)ubase; const f32x4* up1 = (const f32x4*)(ubase + 4 * 4096);
#pragma unroll
      for (int g4 = 0; g4 < 4; ++g4) { const f32x4 a = up[g4], bq = up1[g4];
#pragma unroll
          for (int q = 0; q < 4; ++q) { P0[4 * g4 + q] = a[q]; P1[4 * g4 + q] = bq[q]; } } }
    asm volatile("s_waitcnt vmcnt(0)" ::: "memory"); SCAN_BAR();
    for (int n = 0; n < 64; ++n) {
        const LAS unsigned char* buf = lds + (n & 1) * SHARED_BYTES;
        const float dec0 = __shfl(decv, n);
        f32x16 O0 = zero16(), O1 = zero16();
#define FR(off, idx) (*(const LAS bf16x8*)(buf + (off) + (idx) * 1024 + lane * 16))
#pragma unroll
        for (int d = 0; d < 4; ++d)
#pragma unroll
            for (int s = 0; s < 2; ++s) { const bf16x8 sb = PACK_STEP(S[d], s);
                P0 = MFMA32(FR(OFF_WT, (d * 2 + 0) * 2 + s), sb, P0); P1 = MFMA32(FR(OFF_WT, (d * 2 + 1) * 2 + s), sb, P1);
                O0 = MFMA32(FR(OFF_QDT, (d * 2 + 0) * 2 + s), sb, O0); O1 = MFMA32(FR(OFF_QDT, (d * 2 + 1) * 2 + s), sb, O1); asm volatile("" ::: "memory"); }
        float dec = dec0; asm volatile("" : "+v"(dec) : "v"(P0[15]), "v"(P1[15]));
        const bf16x8 v00 = PACK_STEP(P0, 0), v01 = PACK_STEP(P0, 1), v10 = PACK_STEP(P1, 0), v11 = PACK_STEP(P1, 1);
        f32x16 U0, U1;
        { const int nn = (n + 1 < 64) ? n + 1 : n;
          const f32x4* up = (const f32x4*)(ubase + (size_t)nn * UNIT_BYTES); const f32x4* up1 = (const f32x4*)(ubase + (size_t)nn * UNIT_BYTES + 4 * 4096);
#pragma unroll
          for (int g4 = 0; g4 < 4; ++g4) { const f32x4 a = up[g4], bq = up1[g4];
#pragma unroll
              for (int q = 0; q < 4; ++q) { U0[4 * g4 + q] = a[q]; U1[4 * g4 + q] = bq[q]; } } }
#pragma unroll
        for (int d = 0; d < 4; ++d) {
#pragma unroll
            for (int i = 0; i < 16; ++i) S[d][i] *= dec;
            S[d] = MFMA32(FR(OFF_KE, (d * 2 + 0) * 2 + 0), v00, S[d]); S[d] = MFMA32(FR(OFF_KE, (d * 2 + 0) * 2 + 1), v01, S[d]);
            S[d] = MFMA32(FR(OFF_KE, (d * 2 + 1) * 2 + 0), v10, S[d]); S[d] = MFMA32(FR(OFF_KE, (d * 2 + 1) * 2 + 1), v11, S[d]);
            asm volatile("" ::: "memory");
        }
        O0 = MFMA32(FR(OFF_ATT, 0), v00, O0); O0 = MFMA32(FR(OFF_ATT, 1), v01, O0);
        O1 = MFMA32(FR(OFF_ATT, 2), v00, O1); O1 = MFMA32(FR(OFF_ATT, 3), v01, O1);
        O1 = MFMA32(FR(OFF_ATT, 4), v10, O1); O1 = MFMA32(FR(OFF_ATT, 5), v11, O1);
#undef FR
        float* const ob = Ob + (size_t)(n * 64) * D;
#pragma unroll
        for (int g4 = 0; g4 < 4; ++g4)
#pragma unroll
            for (int q = 0; q < 4; ++q) { float* r0 = ob + (size_t)(8 * g4 + q) * D; r0[loff] = O0[4 * g4 + q]; r0[32 * D + loff] = O1[4 * g4 + q]; }
        P0 = U0; P1 = U1;
        asm volatile("s_waitcnt lgkmcnt(0)" ::: "memory"); SCAN_BAR();
    }
}
#define XB_TMO      128
#define XB_XCNT(j)  (256  + 64 * (j))
#define XB_XSUB(j)  (1280 + 64 * (j))
#define XB_XGEN(j)  (2304 + 64 * (j))
#define XB_TOP      3328
#define XB_TOPGEN   3392
#define XCD_BAR_WORDS 3456
#define XB_SPIN_CAP (1u << 18)

__device__ __forceinline__ unsigned xb_ld(unsigned* p)              { return __hip_atomic_load(p, __ATOMIC_RELAXED, __HIP_MEMORY_SCOPE_AGENT); }
__device__ __forceinline__ unsigned xb_add(unsigned* p, unsigned v) { return __hip_atomic_fetch_add(p, v, __ATOMIC_RELAXED, __HIP_MEMORY_SCOPE_AGENT); }
__device__ __forceinline__ unsigned xb_xcc_id() { return (unsigned)__builtin_amdgcn_s_getreg((3 << 11) | 20) & 0xFu; }
#define XB_SPIN(cond, bar) do { unsigned _sp = 0; while (cond) { __builtin_amdgcn_s_sleep(1); \
    if ((++_sp & 255u) == 0u) { if (xb_ld(&(bar)[XB_TMO])) break; if (_sp > XB_SPIN_CAP) { atomicAdd(&(bar)[XB_TMO], 1u); break; } } } } while (0)

struct XcdBarrier {
    unsigned* bar; unsigned x;
    volatile LAS unsigned* st;
};

__device__ __forceinline__ XcdBarrier xcd_barrier_post(unsigned* bar, volatile LAS unsigned* st) {
    XcdBarrier b; b.bar = bar; b.x = xb_xcc_id(); b.st = st;
    if (threadIdx.x == 0) (void)xb_add(&bar[XB_XCNT(b.x)], 1u);
    return b;
}
__device__ __forceinline__ void xcd_barrier_complete(unsigned* bar, unsigned x, unsigned& nloc, unsigned& nx) {
    const unsigned G = gridDim.x * gridDim.y * gridDim.z;
    unsigned sum, cnt, mine, sp = 0u;
    for (;;) {
        sum = 0u; cnt = 0u; mine = 0u;
#pragma unroll
        for (unsigned j = 0; j < 16; ++j) { const unsigned c = xb_ld(&bar[XB_XCNT(j)]); sum += c; cnt += (c > 0u) ? 1u : 0u; mine = (j == x) ? c : mine; }
        if (sum == G) break;
        __builtin_amdgcn_s_sleep(1);
        if ((++sp & 255u) == 0u) { if (xb_ld(&bar[XB_TMO])) break; if (sp > XB_SPIN_CAP) { atomicAdd(&bar[XB_TMO], 1u); break; } }
    }
    nloc = mine > 0u ? mine : 1u; nx = cnt > 0u ? cnt : 1u;
}

__device__ __forceinline__ void xcd_barrier(const XcdBarrier& b) {
    asm volatile("s_waitcnt vmcnt(0)" ::: "memory");
    __syncthreads();
    if (threadIdx.x == 0) {
        unsigned* bar = b.bar;
        __builtin_amdgcn_s_waitcnt(0);
        unsigned nloc = b.st[0], nx = b.st[1];
        if (nloc == 0u) { xcd_barrier_complete(bar, b.x, nloc, nx); b.st[0] = nloc; b.st[1] = nx; }
        const unsigned old = xb_add(&bar[XB_XSUB(b.x)], 1u);
        const unsigned gen = old / nloc;
        if (old + 1u == (gen + 1u) * nloc) {
            __builtin_amdgcn_fence(__ATOMIC_RELEASE, "agent");
            asm volatile("s_waitcnt vmcnt(0)" ::: "memory");
            const unsigned og = xb_add(&bar[XB_TOP], 1u);
            const unsigned tg = og / nx;
            if (og + 1u == (tg + 1u) * nx) xb_add(&bar[XB_TOPGEN], 1u);
            else XB_SPIN(xb_ld(&bar[XB_TOPGEN]) == tg, bar);
            __builtin_amdgcn_fence(__ATOMIC_ACQUIRE, "agent");
            xb_add(&bar[XB_XGEN(b.x)], 1u);
            asm volatile("s_waitcnt vmcnt(0)" ::: "memory");
        } else {
            XB_SPIN(xb_ld(&bar[XB_XGEN(b.x)]) == gen, bar);
            __builtin_amdgcn_fence(__ATOMIC_ACQUIRE, "agent");
            asm volatile("s_waitcnt vmcnt(0)" ::: "memory");
        }
    }
    __syncthreads();
}
constexpr int RING_BYTES = 131072;
constexpr int MISC_OFF = 143360;
constexpr int LDS_BYTES = 147456;
constexpr int CW_BAR = 4096;
constexpr size_t CTL_ZERO_BYTES = 1 * MiB;

#ifndef REP_EW
#define REP_EW 1
#endif
#ifndef REP_CHUNK
#define REP_CHUNK 1
#endif
#ifndef REP_SCAN
#define REP_SCAN 1
#endif
#ifndef REP_CONV
#define REP_CONV 1
#endif
#define GRID_BAR() xcd_barrier(bar)
#define WSB(off) ((bf16*)(wsp(T) + (off)))
#define SSP(k) ((unsigned long long*)(wsp(T) + WS_SS) + (size_t)(k) * M)
#define OPQ(x) opq_s((int)(x))
DI int opq_s(int x) { asm volatile("" : "+s"(x)); return x; }
template <int l> DI void layer_body(PTab T, LAS unsigned char* lds, const XcdBarrier& bar) {
        ph_ba(T, l, SSP(2 * l));
        { pg8::Gemm g{WSB(WS_H), WSB(WS_WIN) + (size_t)l * NIN * D, M, NPROJ, D, D, D, 0};
          pg8::StaticOrder S; S.init(M, NPROJ, OPQ(gridDim.x), OPQ(blockIdx.x)); pg8::EpiBf16 E{WSB(WS_PROJ), NPROJ, SSP(2 * l), 1.0f / D, EPS};
          pg8::gemm_phase<pg8::EpiBf16, pg8::StaticOrder, true, true>(lds, g, S, E); }
        GRID_BAR();
        for (int rep_ = 0; rep_ < REP_CHUNK; ++rep_) {
            ph_gdn_chunks(T, l, lds);
        }
        for (int rep_ = 0; rep_ < REP_EW; ++rep_) {
            ph_pooled(T);
        }
        GRID_BAR();
        if (blockIdx.x < BATCH * NH) { for (int rep_ = 0; rep_ < REP_SCAN; ++rep_) { if (rep_) __syncthreads(); ph_gdn_scan(T, lds, blockIdx.x); } }
        else { pg8::Gemm g{WSB(WS_POOLED), WSB(WS_WPL) + (size_t)l * D * 512, M, D, 512, D, 512, 2};
          pg8::StaticOrder S; S.init(M, D, OPQ(gridDim.x) - BATCH * NH, OPQ(blockIdx.x) - BATCH * NH); pg8::EpiBf16 E{WSB(WS_YB), D, nullptr, 0.f, 0.f};
          pg8::gemm_phase<pg8::EpiBf16, pg8::StaticOrder, true, true>(lds, g, S, E); }
        GRID_BAR();
        for (int rep_ = 0; rep_ < REP_EW; ++rep_) {
            ph_mix(T, l);
        }
        GRID_BAR();
        { pg8::Gemm g{WSB(WS_MIXED), WSB(WS_WOUT) + (size_t)l * D * D, M, D, D, D, D, 0};
          pg8::StaticOrder S; S.init(M, D, OPQ(gridDim.x), OPQ(blockIdx.x)); pg8::EpiResF32 E{l == 0 ? inp(T, I_X) : outp(T), outp(T), WSB(WS_H), SSP(2 * l + 1), D};
          pg8::gemm_phase<pg8::EpiResF32, pg8::StaticOrder, true, true>(lds, g, S, E); }
        GRID_BAR();
        { pg8::Gemm g{WSB(WS_H), WSB(WS_WUP) + (size_t)l * 2 * DFF * D, M, 2 * DFF, D, D, D, 0};
          pg8::StaticOrder S; S.init(M, 2 * DFF, OPQ(gridDim.x), OPQ(blockIdx.x));
          pg8::EpiGlu E{WSB(WS_BIG2), inp(T, I_CFW) + (size_t)l * 3 * DFF, inp(T, I_CFB) + (size_t)l * DFF, (float*)(wsp(T) + WS_EDGE), (LAS float*)(lds + RING_BYTES), DFF, SSP(2 * l + 1), 1.0f / D, EPS};
          pg8::gemm_phase<pg8::EpiGlu, pg8::StaticOrder, true, true>(lds, g, S, E); }
        GRID_BAR();
        ph_glu_fix(T, l);
        GRID_BAR();
        { pg8::Gemm g{WSB(WS_BIG2), WSB(WS_WDN) + (size_t)l * D * DFF, M, D, DFF, DFF, DFF, 0};
          pg8::StaticOrder S; S.init(M, D, OPQ(gridDim.x), OPQ(blockIdx.x)); pg8::EpiResF32 E{outp(T), outp(T), WSB(WS_H), SSP(2 * l + 2), D};
          pg8::gemm_phase<pg8::EpiResF32, pg8::StaticOrder, true, true>(lds, g, S, E); }
        GRID_BAR();
}
constexpr int TAB_OFF = MISC_OFF + 256;
__global__ void __launch_bounds__(NTHREADS, 2) mega_fwd(Ctx c) {
    extern __shared__ __attribute__((aligned(16))) unsigned char lds_raw[];
    LAS unsigned char* lds = (LAS unsigned char*)lds_raw;
    for (int u = threadIdx.x; u < (LDS_BYTES - MISC_OFF) / 4; u += NTHREADS) ((LAS unsigned*)(lds + MISC_OFF))[u] = 0u;
    __syncthreads();
    if (threadIdx.x < 16) ((LAS unsigned long long*)(lds + TAB_OFF))[threadIdx.x] = (unsigned long long)c.in[threadIdx.x];
    if (threadIdx.x == 16) ((LAS unsigned long long*)(lds + TAB_OFF))[16] = (unsigned long long)c.out;
    if (threadIdx.x == 17) ((LAS unsigned long long*)(lds + TAB_OFF))[17] = (unsigned long long)c.ws;
    __syncthreads();
    const PTab T = (PTab)(lds + TAB_OFF);
    XcdBarrier bar = xcd_barrier_post((unsigned*)(wsp(T) + WS_CTL) + CW_BAR, (volatile LAS unsigned*)(lds + MISC_OFF) + 8);

    for (int rep_ = 0; rep_ < REP_CONV; ++rep_) ph_convert(T, lds);
    GRID_BAR();
    layer_body<0>(T, lds, bar); layer_body<1>(T, lds, bar); layer_body<2>(T, lds, bar); layer_body<3>(T, lds, bar);
    const bool poison = __hip_atomic_load((unsigned*)(wsp(T) + WS_CTL) + CW_BAR + XB_TMO, __ATOMIC_RELAXED, __HIP_MEMORY_SCOPE_AGENT) != 0u;
    ph_final_norm(outp(T), inp(T, I_NFIN), SSP(8));
    if (poison) { asm volatile("s_waitcnt vmcnt(0)" ::: "memory"); float* X = outp(T); const float q = __builtin_nanf(""); for (size_t e = (size_t)blockIdx.x * NTHREADS + threadIdx.x; e < (size_t)M * D; e += (size_t)gridDim.x * NTHREADS) X[e] = q; }
#undef GRID_BAR
#undef WSB
}

extern "C" void kernel_launch(void* const* d_in, const int* in_sizes, int n_in, void* d_out, int out_size, void* d_ws, size_t ws_size, hipStream_t stream) {
    static int grid = 0;
    if (grid == 0) {
        if (n_in != 16 || out_size != M * D || ws_size < WS_END) { fprintf(stderr, "kernel_launch: unexpected shapes (n_in %d, out %d, ws %zu)\n", n_in, out_size, ws_size); grid = -1; return; }
        int dev = 0, cus = 0, per_cu = 0;
        if (hipGetDevice(&dev) != hipSuccess || hipDeviceGetAttribute(&cus, hipDeviceAttributeMultiprocessorCount, dev) != hipSuccess) { grid = -1; return; }
        if (hipFuncSetAttribute((const void*)mega_fwd, hipFuncAttributeMaxDynamicSharedMemorySize, LDS_BYTES) != hipSuccess) { fprintf(stderr, "kernel_launch: hipFuncSetAttribute failed\n"); grid = -1; return; }
        if (hipOccupancyMaxActiveBlocksPerMultiprocessor(&per_cu, (const void*)mega_fwd, NTHREADS, LDS_BYTES) != hipSuccess || per_cu < 1) fprintf(stderr, "kernel_launch: occupancy query says %d\n", per_cu);
        (void)hipGetLastError();
        grid = cus;
    }
    if (grid < 0) return;
    if (hipMemsetAsync((char*)d_ws + WS_CTL, 0, CTL_ZERO_BYTES, stream) != hipSuccess) return;
    if (hipMemsetAsync((char*)d_ws + WS_SS, 0, SS_BYTES, stream) != hipSuccess) return;
    Ctx c{};
    for (int i = 0; i < 16; ++i) c.in[i] = (const float*)d_in[i];
    c.out = (float*)d_out; c.ws = (unsigned char*)d_ws;
    hipLaunchKernelGGL(mega_fwd, dim3(grid), dim3(NTHREADS), LDS_BYTES, stream, c);
}
```

```cpp
#include <hip/hip_runtime.h>
#include <cstdio>
#include <cstdint>

namespace pg8 {
#define PG8_LAS __attribute__((address_space(3)))
typedef unsigned short bf16_t;
typedef short bf16x8 __attribute__((ext_vector_type(8)));
typedef float f32x4 __attribute__((ext_vector_type(4)));
typedef unsigned u32x4 __attribute__((ext_vector_type(4)));
constexpr int BM = 256, BK = 64, HALF = 128, HTB = HALF * BK * 2  , STAGE_BYTES = 8 * HTB, NXCD = 8, WGM = 8;

__host__ __device__ __forceinline__ int lds_byte(int r, int c) { const int st = (r >> 4) * 2 + (c >> 5), rr = r & 15, cc = c & 31, ob = rr * 64 + cc * 2; return st * 1024 + (ob ^ (((ob >> 9) & 1) << 5)); }
__host__ __device__ __forceinline__ void stage_rc(int b, int& R, int& C) { const int st = b / 1024, sb = b % 1024, swz = sb ^ (((sb >> 9) & 1) << 5); R = (st >> 1) * 16 + swz / 64; C = (st & 1) * 32 + (swz % 64) / 2; }
__host__ __device__ __forceinline__ int perm32(int rho) { const int n = rho >> 4, i = rho & 15; return 8 * (i >> 2) + 4 * n + (i & 3); }

struct Unit { int pm, pn; };
struct Gemm { const bf16_t* A; const bf16_t* Bt; int M, N, K, lda, ldb, agrp; };

struct StaticOrder {
    int nM, nN, nwg, G, c;
    __host__ __device__ void init(int M, int N, int G_, int c_) { nM = M / BM; nN = N / BM; nwg = nM * nN; G = G_; c = c_; }
    __host__ __device__ bool next(int i, Unit& u) const {
        const long L = (long)i * G + c; if (L >= nwg) return false;
        int wgid = (int)L; { const int q = nwg / NXCD, r = nwg % NXCD, xcd = wgid % NXCD, off = wgid / NXCD; wgid = (xcd < r ? xcd * (q + 1) : r * (q + 1) + (xcd - r) * q) + off; }
        const int nig = WGM * nN, gid = wgid / nig, fm = gid * WGM, gsz = (nM - fm) < WGM ? (nM - fm) : WGM;
        u.pm = fm + ((wgid % nig) % gsz); u.pn = (wgid % nig) / gsz; return true;
    }
    __device__ __forceinline__ void a_ready(const Unit&) const {}
    __device__ __forceinline__ void done(const Unit&) const {}
};

__device__ __forceinline__ unsigned cvt_pk_bf16(float lo, float hi) { unsigned r; asm volatile("v_cvt_pk_bf16_f32 %0, %1, %2" : "=v"(r) : "v"(lo), "v"(hi)); return r; }
typedef float f32x2 __attribute__((ext_vector_type(2)));

struct EpiBf16 {
    static constexpr bool PERM = true, AFTER_DRAIN = false;
    bf16_t* O; int ldc;
    __device__ __forceinline__ void operator()(const f32x4 (&acc)[2][2][4][2], const Unit& u, int wr, int wc, int fr, int fq) const {
        const int row0 = u.pm * BM + wr * 64 + fr; const int col0 = u.pn * BM + wc * 32 + 8 * fq;
#pragma unroll
        for (int ai = 0; ai < 2; ++ai)
#pragma unroll
            for (int m = 0; m < 4; ++m) { bf16_t* rowp = O + (size_t)(row0 + ai * HALF + m * 16) * ldc + col0;
#pragma unroll
                for (int bj = 0; bj < 2; ++bj) { const f32x4 v0 = acc[ai][bj][m][0], v1 = acc[ai][bj][m][1];
                    u32x4 w; w.x = cvt_pk_bf16(v0[0], v0[1]); w.y = cvt_pk_bf16(v0[2], v0[3]); w.z = cvt_pk_bf16(v1[0], v1[1]); w.w = cvt_pk_bf16(v1[2], v1[3]);
                    *(u32x4*)(rowp + bj * HALF) = w; } }
    }
};
struct EpiResF32 {
    static constexpr bool PERM = false, AFTER_DRAIN = false;
    const float* base; float* out; int ldc;
    __device__ __forceinline__ void operator()(const f32x4 (&acc)[2][2][4][2], const Unit& u, int wr, int wc, int fr, int fq) const {
        const int row0 = u.pm * BM + wr * 64 + fr, col0 = u.pn * BM + wc * 32 + 4 * fq;
#pragma unroll
        for (int ai = 0; ai < 2; ++ai)
#pragma unroll
            for (int m = 0; m < 4; ++m) { const size_t off = (size_t)(row0 + ai * HALF + m * 16) * ldc + col0;
                f32x4 bs[2][2];
#pragma unroll
                for (int bj = 0; bj < 2; ++bj)
#pragma unroll
                    for (int n = 0; n < 2; ++n) bs[bj][n] = *(const f32x4*)(base + off + bj * HALF + n * 16);
#pragma unroll
                for (int bj = 0; bj < 2; ++bj)
#pragma unroll
                    for (int n = 0; n < 2; ++n) *(f32x4*)(out + off + bj * HALF + n * 16) = bs[bj][n] + acc[ai][bj][m][n];
                asm volatile("" ::: "memory"); }
    }
};

__device__ __forceinline__ f32x2 gelu_pk(f32x2 v) {
    const f32x2 av = __builtin_elementwise_abs(v), d = av * 0.2316418882f + 1.0f;
    f32x2 t; t.x = __builtin_amdgcn_rcpf(d.x); t.y = __builtin_amdgcn_rcpf(d.y);
    f32x2 q = t * 0.5307027145f + (-0.7265760135f); q = q * t + 0.7107068705f; q = q * t + (-0.142248368f); q = q * t + 0.127414796f; q = q * t;
    const f32x2 s = (v * v) * (-0.72134752044f);
    f32x2 e; e.x = __builtin_amdgcn_exp2f(s.x); e.y = __builtin_amdgcn_exp2f(s.y);
    const f32x2 m = v * (q * e), r = v - m;
    f32x2 o; o.x = v.x < 0.f ? m.x : r.x; o.y = v.y < 0.f ? m.y : r.y; return o;
}
template <int N> __device__ __forceinline__ float row_ror(float x) { return __builtin_bit_cast(float, __builtin_amdgcn_update_dpp(0, __builtin_bit_cast(int, x), 0x120 + N, 0xf, 0xf, false)); }
struct EpiGlu {
    static constexpr bool PERM = true, AFTER_DRAIN = false;
    bf16_t* ACT; const float* cw; const float* cb; float* edge; PG8_LAS float* xb; int dff;
    __device__ __forceinline__ void operator()(const f32x4 (&acc)[2][2][4][2], const Unit& u, int wr, int wc, int fr, int fq) const {
        const int f0 = u.pn * 128 + wc * 32 + 8 * fq;
        if (fr >= 14) {
#pragma unroll
            for (int ai = 0; ai < 2; ++ai) { PG8_LAS f32x4* p = (PG8_LAS f32x4*)(xb + ((((wr * 2 + ai) * 4 + wc) * 2 + (fr - 14)) * 32 + 8 * fq)); p[0] = acc[ai][0][3][0]; p[1] = acc[ai][0][3][1]; }
        }
        asm volatile("s_waitcnt lgkmcnt(0)" ::: "memory"); __builtin_amdgcn_s_barrier(); asm volatile("" ::: "memory");
        f32x4 w0[2], w1[2], w2[2], bb[2];
#pragma unroll
        for (int n = 0; n < 2; ++n) { w0[n] = *(const f32x4*)(cw + f0 + 4 * n); w1[n] = *(const f32x4*)(cw + dff + f0 + 4 * n); w2[n] = *(const f32x4*)(cw + 2 * dff + f0 + 4 * n); bb[n] = *(const f32x4*)(cb + f0 + 4 * n); }
        const bool seq_start = (u.pm & 15) == 0;
#pragma unroll
        for (int ai = 0; ai < 2; ++ai) {
            f32x4 pr1[2], pr2[2];
            if (wr == 1 || ai == 1) { const int swr = (wr == 1) ? 0 : 1, sai = (wr == 1) ? ai : 0; const PG8_LAS f32x4* p = (const PG8_LAS f32x4*)(xb + ((((swr * 2 + sai) * 4 + wc) * 2) * 32 + 8 * fq));
                const f32x4 a0 = p[0], a1 = p[1], b0 = p[8], b1 = p[9]; pr1[0] = b0; pr1[1] = b1; pr2[0] = (fr == 0) ? a0 : b0; pr2[1] = (fr == 0) ? a1 : b1; }
            else { pr1[0] = pr1[1] = pr2[0] = pr2[1] = (f32x4){0.f, 0.f, 0.f, 0.f}; }
            const bool defer_blk = (ai == 0) && (wr == 0) && !seq_start;
#pragma unroll
            for (int m = 0; m < 4; ++m) {
                const int row = u.pm * BM + ai * HALF + wr * 64 + m * 16 + fr; u32x4 w;
#pragma unroll
                for (int n = 0; n < 2; ++n) { const f32x4 g = acc[ai][0][m][n], up = acc[ai][1][m][n]; f32x4 r1, r2, a;
                    r1[0] = row_ror<1>(g[0]); r1[1] = row_ror<1>(g[1]); r1[2] = row_ror<1>(g[2]); r1[3] = row_ror<1>(g[3]);
                    r2[0] = row_ror<2>(g[0]); r2[1] = row_ror<2>(g[1]); r2[2] = row_ror<2>(g[2]); r2[3] = row_ror<2>(g[3]);
#pragma unroll
                    for (int e = 0; e < 4; ++e) { const float p1 = (fr >= 1) ? r1[e] : pr1[n][e], p2 = (fr >= 2) ? r2[e] : pr2[n][e]; a[e] = w0[n][e] * p2 + w1[n][e] * p1 + w2[n][e] * g[e] + bb[n][e]; }
                    pr1[n] = r1; pr2[n] = r2;
                    const f32x2 x0 = gelu_pk((f32x2){a[0], a[1]}), x1 = gelu_pk((f32x2){a[2], a[3]});
                    const unsigned lo = cvt_pk_bf16(x0.x * up[0], x0.y * up[1]), hi = cvt_pk_bf16(x1.x * up[2], x1.y * up[3]);
                    if (n == 0) { w.x = lo; w.y = hi; } else { w.z = lo; w.w = hi; } }
                if (defer_blk && m == 0 && fr < 2) { float* eg = edge + ((size_t)((1 * 64 + u.pm) * 2 + fr)) * dff + f0; float* eu = edge + ((size_t)((2 * 64 + u.pm) * 2 + fr)) * dff + f0;
                    *(f32x4*)eg = acc[0][0][0][0]; *(f32x4*)(eg + 4) = acc[0][0][0][1]; *(f32x4*)eu = acc[0][1][0][0]; *(f32x4*)(eu + 4) = acc[0][1][0][1]; }
                else *(u32x4*)(ACT + (size_t)row * dff + f0) = w;
                if (ai == 1 && wr == 1 && m == 3 && fr >= 14) { float* el = edge + ((size_t)((0 * 64 + u.pm) * 2 + (fr - 14))) * dff + f0; *(f32x4*)el = acc[1][0][3][0]; *(f32x4*)(el + 4) = acc[1][0][3][1]; }
            }
        }
    }
};

template <class Epi, class Sched, bool ALIGN_EPI = false, bool SP2 = false>
__device__ __forceinline__ void gemm_phase(PG8_LAS unsigned char* lds, const Gemm g, const Sched& S, const Epi& E) {
    int tid_ = threadIdx.x; asm volatile("" : "+v"(tid_));
    const int tid = tid_, wid = __builtin_amdgcn_readfirstlane(tid >> 6), lane = tid & 63, wr = wid >> 2, wc = wid & 3, fr = lane & 15, fq = lane >> 4;
    const int K = g.K, nt = K / BK;
    unsigned voffA[2], voffB[2];
#pragma unroll
    for (int i = 0; i < 2; ++i) { int R, C; stage_rc(tid * 16 + i * 8192, R, C); const int Rb = Epi::PERM ? ((R & ~31) + perm32(R & 31)) : R;
        voffA[i] = (unsigned)(R * g.lda + C) * 2u; voffB[i] = (unsigned)(Rb * g.ldb + C) * 2u; }
    const size_t kstep = (size_t)(BK * 2);
    const size_t hsA = (size_t)HALF * g.lda * 2, hsB = (size_t)HALF * g.ldb * 2;
    const size_t tsA = 2 * hsA, tsB = 2 * hsB;
#define PG8_UA(u) ((const char*)g.A + (size_t)(u).pm * tsA + (g.agrp ? (size_t)((u).pn / g.agrp) * (size_t)K * 2 : (size_t)0))
#define PG8_UB(u) ((const char*)g.Bt + (size_t)(u).pn * tsB)
    const unsigned ldsw = (unsigned)wid * 1024u;
    const int aoff = lds_byte(wr * 64 + fr, fq * 8), boff = lds_byte(wc * 32 + fr, fq * 8);
#define PG8_SA(b, h) (((b) * 2 + (h)) * HTB)
#define PG8_SB(b, h) ((4 + (b) * 2 + (h)) * HTB)
#define PG8_STAGE(bufoff, gbase, voff) do { _Pragma("unroll") for (int _i = 0; _i < 2; ++_i) \
        __builtin_amdgcn_global_load_lds((const unsigned*)((const char*)(gbase) + (voff)[_i]), (PG8_LAS unsigned*)(lds + (bufoff) + ldsw + _i * 8192), 16, 0, 0); } while (0)
#define PG8_LDA(dst, b, h) do { _Pragma("unroll") for (int m = 0; m < 4; ++m) _Pragma("unroll") for (int k = 0; k < 2; ++k) dst[m][k] = *(const PG8_LAS bf16x8*)(lds + PG8_SA(b, h) + aoff + m * 2048 + k * 1024); } while (0)
#define PG8_LDB(dst, b, h) do { _Pragma("unroll") for (int n = 0; n < 2; ++n) _Pragma("unroll") for (int k = 0; k < 2; ++k) dst[n][k] = *(const PG8_LAS bf16x8*)(lds + PG8_SB(b, h) + boff + n * 2048 + k * 1024); } while (0)
#define PG8_MMA(ai, bj, At, Bt) do { __builtin_amdgcn_s_setprio(1); _Pragma("unroll") for (int m = 0; m < 4; ++m) _Pragma("unroll") for (int n = 0; n < 2; ++n) _Pragma("unroll") for (int k = 0; k < 2; ++k) \
        acc[ai][bj][m][n] = __builtin_amdgcn_mfma_f32_16x16x32_bf16(Bt[n][k], At[m][k], acc[ai][bj][m][n], 0, 0, 0); __builtin_amdgcn_s_setprio(0); } while (0)
#define PG8_WAIT_V(n) asm volatile("s_waitcnt vmcnt(" #n ")" ::: "memory")
#define PG8_WAIT_L(n) asm volatile("s_waitcnt lgkmcnt(" #n ")" ::: "memory")
#define PG8_BAR __builtin_amdgcn_s_barrier()
#define PG8_SCHED __builtin_amdgcn_sched_barrier(0)
    Unit cur, nxt; int ui = 0;
    if (!S.next(0, cur)) return;
    f32x4 acc[2][2][4][2];
#pragma unroll
    for (int a = 0; a < 2; ++a)
#pragma unroll
        for (int b = 0; b < 2; ++b)
#pragma unroll
            for (int m = 0; m < 4; ++m)
#pragma unroll
                for (int n = 0; n < 2; ++n) acc[a][b][m][n] = (f32x4){0.f, 0.f, 0.f, 0.f};
    bf16x8 At[4][2], B0[2][2], B1[2][2];
    const char* cA = PG8_UA(cur); const char* cB = PG8_UB(cur);
    S.a_ready(cur);
    if constexpr (SP2) {
        PG8_STAGE(PG8_SB(0, 0), cB, voffB); PG8_STAGE(PG8_SB(0, 1), cB + hsB, voffB); PG8_STAGE(PG8_SA(0, 0), cA, voffA); PG8_STAGE(PG8_SA(0, 1), cA + hsA, voffA);
        if (wr == 1) PG8_BAR;
        PG8_WAIT_V(2); PG8_BAR;
        PG8_STAGE(PG8_SB(1, 0), cB + kstep, voffB); PG8_STAGE(PG8_SA(1, 0), cA + kstep, voffA); PG8_STAGE(PG8_SB(1, 1), cB + hsB + kstep, voffB);
        PG8_WAIT_V(6); PG8_BAR;
    } else {
        PG8_STAGE(PG8_SB(0, 0), cB, voffB); PG8_STAGE(PG8_SA(0, 0), cA, voffA); PG8_STAGE(PG8_SB(0, 1), cB + hsB, voffB); PG8_STAGE(PG8_SA(0, 1), cA + hsA, voffA);
        if (wr == 1) PG8_BAR;
        PG8_WAIT_V(4); PG8_BAR;
        PG8_STAGE(PG8_SB(1, 0), cB + kstep, voffB); PG8_STAGE(PG8_SA(1, 0), cA + kstep, voffA); PG8_STAGE(PG8_SB(1, 1), cB + hsB + kstep, voffB);
        PG8_WAIT_V(6); PG8_BAR;
    }
    for (;;) {
        const bool has_next = S.next(ui + 1, nxt);
        const char* nA = has_next ? PG8_UA(nxt) : cA; const char* nB = has_next ? PG8_UB(nxt) : cB;
        for (int t = 0; t < nt; t += 2) {
            const bool last = (t == nt - 2);
            const char* a1 = cA + (size_t)(t + 1) * kstep;
            const char* a2 = last ? nA : cA + (size_t)(t + 2) * kstep; const char* b2 = last ? nB : cB + (size_t)(t + 2) * kstep;
            const char* a3 = a2 + kstep; const char* b3 = b2 + kstep;
            if (last && has_next) S.a_ready(nxt);
            if constexpr (SP2) {
            PG8_LDB(B0, 0, 0); PG8_LDB(B1, 0, 1); PG8_SCHED; PG8_LDA(At, 0, 0); PG8_STAGE(PG8_SA(1, 1), a1 + hsA, voffA);
            PG8_WAIT_V(8); PG8_WAIT_L(0); PG8_BAR; PG8_MMA(0, 0, At, B0); PG8_MMA(0, 1, At, B1); PG8_BAR; PG8_SCHED;
            PG8_LDA(At, 0, 1); PG8_STAGE(PG8_SB(0, 0), b2, voffB); PG8_STAGE(PG8_SB(0, 1), b2 + hsB, voffB); PG8_STAGE(PG8_SA(0, 0), a2, voffA);
            PG8_WAIT_V(8); PG8_WAIT_L(0); PG8_BAR; PG8_MMA(1, 0, At, B0); PG8_MMA(1, 1, At, B1); PG8_BAR; PG8_SCHED;
            PG8_LDB(B0, 1, 0); PG8_LDB(B1, 1, 1); PG8_SCHED; PG8_LDA(At, 1, 0); PG8_STAGE(PG8_SA(0, 1), a2 + hsA, voffA);
            PG8_WAIT_V(8); PG8_WAIT_L(0); PG8_BAR; PG8_MMA(0, 0, At, B0); PG8_MMA(0, 1, At, B1); PG8_BAR; PG8_SCHED;
            PG8_LDA(At, 1, 1); PG8_STAGE(PG8_SB(1, 0), b3, voffB); PG8_STAGE(PG8_SB(1, 1), b3 + hsB, voffB); PG8_STAGE(PG8_SA(1, 0), a3, voffA);
            PG8_WAIT_V(8); PG8_WAIT_L(0); PG8_BAR; PG8_MMA(1, 0, At, B0); PG8_MMA(1, 1, At, B1); PG8_BAR; PG8_SCHED;
            } else {
            PG8_LDB(B0, 0, 0); PG8_SCHED; PG8_LDA(At, 0, 0); PG8_STAGE(PG8_SA(1, 1), a1 + hsA, voffA);
            PG8_WAIT_L(8); PG8_BAR; PG8_WAIT_L(0); PG8_MMA(0, 0, At, B0); PG8_BAR; PG8_SCHED;
            PG8_LDB(B1, 0, 1); PG8_STAGE(PG8_SB(0, 0), b2, voffB);
            PG8_BAR; PG8_WAIT_L(0); PG8_MMA(0, 1, At, B1); PG8_BAR;
            PG8_LDA(At, 0, 1); PG8_STAGE(PG8_SA(0, 0), a2, voffA);
            PG8_BAR; PG8_WAIT_L(0); PG8_MMA(1, 0, At, B0); PG8_BAR; PG8_SCHED;
            PG8_STAGE(PG8_SB(0, 1), b2 + hsB, voffB);
            PG8_WAIT_V(6); PG8_BAR; PG8_MMA(1, 1, At, B1); PG8_BAR;
            PG8_LDB(B0, 1, 0); PG8_SCHED; PG8_LDA(At, 1, 0); PG8_STAGE(PG8_SA(0, 1), a2 + hsA, voffA);
            PG8_WAIT_L(8); PG8_BAR; PG8_WAIT_L(0); PG8_MMA(0, 0, At, B0); PG8_BAR; PG8_SCHED;
            PG8_LDB(B1, 1, 1); PG8_STAGE(PG8_SB(1, 0), b3, voffB);
            PG8_BAR; PG8_WAIT_L(0); PG8_MMA(0, 1, At, B1); PG8_BAR;
            PG8_LDA(At, 1, 1); PG8_STAGE(PG8_SA(1, 0), a3, voffA);
            PG8_BAR; PG8_WAIT_L(0); PG8_MMA(1, 0, At, B0); PG8_BAR; PG8_SCHED;
            PG8_STAGE(PG8_SB(1, 1), b3 + hsB, voffB);
            PG8_WAIT_V(6); PG8_BAR; PG8_MMA(1, 1, At, B1); PG8_BAR;
            }
        }
        if constexpr (ALIGN_EPI) { if (wr == 0) PG8_BAR; }
        if constexpr (!Epi::AFTER_DRAIN) { E(acc, cur, wr, wc, fr, fq); S.done(cur); }
        if (!has_next) break;
#pragma unroll
        for (int a = 0; a < 2; ++a)
#pragma unroll
            for (int b = 0; b < 2; ++b)
#pragma unroll
                for (int m = 0; m < 4; ++m)
#pragma unroll
                    for (int n = 0; n < 2; ++n) acc[a][b][m][n] = (f32x4){0.f, 0.f, 0.f, 0.f};
        cur = nxt; cA = nA; cB = nB; ++ui;
        if constexpr (ALIGN_EPI) { if (wr == 1) PG8_BAR; }
    }
    PG8_WAIT_V(0);
    if constexpr (!ALIGN_EPI) { if (wr == 0) PG8_BAR; }
    PG8_BAR;
    if constexpr (Epi::AFTER_DRAIN) { E.fused(acc, cur, wr, wc, fr, fq, lds, wid, lane); S.done(cur); }
#undef PG8_UA
#undef PG8_UB
#undef PG8_SA
#undef PG8_SB
#undef PG8_STAGE
#undef PG8_LDA
#undef PG8_LDB
#undef PG8_MMA
#undef PG8_WAIT_V
#undef PG8_WAIT_L
#undef PG8_BAR
#undef PG8_SCHED
}
}

typedef unsigned short bf16;
typedef short bf16x8 __attribute__((ext_vector_type(8)));
typedef float f32x4 __attribute__((ext_vector_type(4)));
typedef unsigned v4u __attribute__((ext_vector_type(4)));
typedef unsigned v2u __attribute__((ext_vector_type(2)));
typedef float f32x2_t __attribute__((ext_vector_type(2)));
#define LAS __attribute__((address_space(3)))
#define DI __device__ __forceinline__
constexpr int D = 2048, BATCH = 4, SEQ = 4096, DEPTH = 4, NH = 16, HD = 128, DFF = 5632;
constexpr int M = BATCH * SEQ;
constexpr int NPROJ = 14336;
constexpr int NIN = 14368;
constexpr int C_Q = 0, C_K = 2048, C_V = 4096, C_Z = 6144, C_P = 8192, C_GA = 10240, C_GB = 12288;
constexpr float EPS = 1e-6f;
constexpr int NWAVES = 8, NTHREADS = 512;

constexpr size_t MiB = 1u << 20;
constexpr size_t WS_CTL = 0;
constexpr size_t WS_WIN = 1 * MiB;
constexpr size_t WS_WOUT = 226 * MiB;
constexpr size_t WS_WUP = 258 * MiB;
constexpr size_t WS_WDN = 434 * MiB;
constexpr size_t WS_WPL = 522 * MiB;
constexpr size_t WS_H = 530 * MiB;
constexpr size_t WS_BA = 594 * MiB;
constexpr size_t WS_BETA = 596 * MiB;
constexpr size_t WS_G = 597 * MiB;
constexpr size_t WS_PROJ = 598 * MiB;
constexpr size_t WS_BIG2 = 1046 * MiB;
constexpr size_t WS_O = 1430 * MiB;
constexpr size_t WS_POOLED = 1558 * MiB;
constexpr size_t WS_YB = 1622 * MiB;
constexpr size_t WS_MIXED = 1686 * MiB;
constexpr size_t WS_EDGE = 1750 * MiB;
constexpr size_t WS_END = 1760 * MiB;
static_assert(WS_WIN + (size_t)4 * NIN * D * 2 <= WS_WOUT && WS_WUP + (size_t)4 * 2 * DFF * D * 2 <= WS_WDN && WS_WDN + (size_t)4 * D * DFF * 2 <= WS_WPL, "ws map");
static_assert(WS_PROJ + (size_t)M * NPROJ * 2 <= WS_BIG2 && WS_BIG2 + (size_t)3 * M * D * 4 <= WS_O, "ws map");

struct Ctx { const float* in[16]; float* out; unsigned char* ws; };
typedef LAS const unsigned long long* PTab;
DI unsigned long long tab_ld(PTab T, int i) { const unsigned long long v = T[i]; const unsigned lo = __builtin_amdgcn_readfirstlane((unsigned)v), hi = __builtin_amdgcn_readfirstlane((unsigned)(v >> 32)); return ((unsigned long long)hi << 32) | lo; }
#define GAS __attribute__((address_space(1)))
DI const float* inp(PTab T, int i) { return (const float*)(const GAS float*)tab_ld(T, i); }
DI float* outp(PTab T) { return (float*)(GAS float*)tab_ld(T, 16); }
DI unsigned char* wsp(PTab T) { return (unsigned char*)(GAS unsigned char*)tab_ld(T, 17); }
enum { I_X = 0, I_NMW, I_WIN, I_CQW, I_ALOG, I_DTB, I_GNW, I_PW, I_PS, I_WOUT, I_NFW, I_WUP, I_CFW, I_CFB, I_WDN, I_NFIN };

DI int otid() { int t = threadIdx.x; asm volatile("" : "+v"(t)); return t; }
DI float bf2f(bf16 b) { return __uint_as_float(((unsigned)b) << 16); }
DI unsigned f2bf(float f) { unsigned u = __float_as_uint(f); return (u + 0x7fffu + ((u >> 16) & 1u)) >> 16; }
DI unsigned pk2(float lo, float hi) { return f2bf(lo) | (f2bf(hi) << 16); }
DI float lo16(unsigned w) { return __uint_as_float(w << 16); }
DI float hi16(unsigned w) { return __uint_as_float(w & 0xffff0000u); }
DI float wave_sum(float v) {
#pragma unroll
    for (int o = 1; o < 64; o <<= 1) v += __shfl_xor(v, o);
    return v;
}
DI float sigmoidf_(float x) { return 1.0f / (1.0f + expf(-x)); }
DI float siluf_(float x) { return x / (1.0f + expf(-x)); }
DI float softplusf_(float x) { return fmaxf(x, 0.f) + log1pf(expf(-fabsf(x))); }
DI float fexp(float x) { return __builtin_amdgcn_exp2f(x * 1.4426950408889634f); }
DI float frcp(float x) { return __builtin_amdgcn_rcpf(x); }
DI float frsq(float x) { return __builtin_amdgcn_rsqf(x); }
DI float fsigmoid(float x) { return frcp(1.0f + fexp(-x)); }
DI float fsilu(float x) { return x * frcp(1.0f + fexp(-x)); }
DI float gelu_erf(float x) { return 0.5f * x * (1.0f + erff(x * 0.70710678118654752f)); }

DI void transpose_item(const float* W, int ldw, int src_col0, int k0, bf16* WT, int K, int dst_row0, LAS float* scr, int lane) {
#pragma unroll 8
    for (int i = 0; i < 32; ++i) { const int kk = 2 * i + (lane >> 5); scr[kk * 33 + (lane & 31)] = W[(size_t)(k0 + kk) * ldw + src_col0 + (lane & 31)]; }
    asm volatile("s_waitcnt lgkmcnt(0)" ::: "memory");
    const int c = lane & 7;
#pragma unroll
    for (int j = 0; j < 4; ++j) { const int n = (lane >> 3) + 8 * j; const LAS float* s = scr + (8 * c) * 33 + n;
        v4u o; o.x = pk2(s[0 * 33], s[1 * 33]); o.y = pk2(s[2 * 33], s[3 * 33]); o.z = pk2(s[4 * 33], s[5 * 33]); o.w = pk2(s[6 * 33], s[7 * 33]);
        *(v4u*)(WT + (size_t)(dst_row0 + n) * K + k0 + 8 * c) = o; }
    asm volatile("s_waitcnt lgkmcnt(0)" ::: "memory");
}
constexpr int IT_IN = (D / 64) * (NIN / 32), IT_OUT = (D / 64) * (D / 32), IT_UP = (D / 64) * (2 * DFF / 32), IT_DN = (DFF / 64) * (D / 32), IT_PL = 4 * (512 / 64) * (512 / 32);
constexpr int IT_LAYER = IT_IN + IT_OUT + IT_UP + IT_DN + IT_PL;
DI void ph_convert(PTab T, LAS unsigned char* lds) {
    const int tid = otid(), lane = tid & 63, wave = __builtin_amdgcn_readfirstlane(tid >> 6), gw = blockIdx.x * NWAVES + wave, ngw = gridDim.x * NWAVES; (void)lane; (void)gw; (void)ngw;
    unsigned char* const ws = wsp(T); (void)ws;
    LAS float* scr = (LAS float*)(lds + wave * 16384);
    for (int it = gw; it < DEPTH * IT_LAYER; it += ngw) {
        const int l = it / IT_LAYER; int r = it % IT_LAYER;
        if (r < IT_IN) { const int nblk = NIN / 32, kb = r / nblk, nb = r % nblk; const int n0 = 32 * nb;
            const int sc = n0 < 8192 ? n0 : (n0 < NPROJ ? n0 + 32 : 8192 + (n0 - NPROJ));
            transpose_item(inp(T, I_WIN) + (size_t)l * D * NIN, NIN, sc, 64 * kb, (bf16*)(ws + WS_WIN) + (size_t)l * NIN * D, D, n0, scr, lane); continue; }
        r -= IT_IN;
        if (r < IT_OUT) { const int nblk = D / 32, kb = r / nblk, nb = r % nblk;
            transpose_item(inp(T, I_WOUT) + (size_t)l * D * D, D, 32 * nb, 64 * kb, (bf16*)(ws + WS_WOUT) + (size_t)l * D * D, D, 32 * nb, scr, lane); continue; }
        r -= IT_OUT;
        if (r < IT_UP) { const int nblk = 2 * DFF / 32, kb = r / nblk, nb = r % nblk;
            const int n0 = 32 * nb, sc = ((n0 >> 7) & 1) * DFF + 128 * (n0 >> 8) + (n0 & 127);
            transpose_item(inp(T, I_WUP) + (size_t)l * D * 2 * DFF, 2 * DFF, sc, 64 * kb, (bf16*)(ws + WS_WUP) + (size_t)l * 2 * DFF * D, D, n0, scr, lane); continue; }
        r -= IT_UP;
        if (r < IT_DN) { const int nblk = D / 32, kb = r / nblk, nb = r % nblk;
            transpose_item(inp(T, I_WDN) + (size_t)l * DFF * D, D, 32 * nb, 64 * kb, (bf16*)(ws + WS_WDN) + (size_t)l * D * DFF, DFF, 32 * nb, scr, lane); continue; }
        r -= IT_DN;
        { const int g = r / 128, rr = r % 128, kb = rr / 16, nb = rr % 16;
            transpose_item(inp(T, I_PW) + (size_t)(l * 4 + g) * 512 * 512, 512, 32 * nb, 64 * kb, (bf16*)(ws + WS_WPL) + (size_t)l * D * 512, 512, g * 512 + 32 * nb, scr, lane); }
    }
}

DI void ph_rmsnorm_bf16(const float* x, const float* w, bf16* out) {
    const int tid = otid(), lane = tid & 63, wave = __builtin_amdgcn_readfirstlane(tid >> 6), gw = blockIdx.x * NWAVES + wave, ngw = gridDim.x * NWAVES;
    for (int m = gw; m < M; m += ngw) {
        const f32x4* xr = (const f32x4*)(x + (size_t)m * D) + lane; f32x4 v[8]; float s = 0.f;
#pragma unroll
        for (int j = 0; j < 8; ++j) { v[j] = xr[64 * j]; s += (v[j].x * v[j].x + v[j].y * v[j].y) + (v[j].z * v[j].z + v[j].w * v[j].w); }
        const float rstd = 1.0f / sqrtf(wave_sum(s) * (1.0f / D) + EPS);
        v2u* o = (v2u*)(out + (size_t)m * D) + lane;
#pragma unroll
        for (int j = 0; j < 8; ++j) { const f32x4 ww = ((const f32x4*)w)[lane + 64 * j]; v2u p; p.x = pk2(v[j].x * rstd * ww.x, v[j].y * rstd * ww.y); p.y = pk2(v[j].z * rstd * ww.z, v[j].w * rstd * ww.w); o[64 * j] = p; }
    }
}
DI void ph_rmsnorm_f32(const float* x, const float* w, float* out) {
    const int tid = otid(), lane = tid & 63, wave = __builtin_amdgcn_readfirstlane(tid >> 6), gw = blockIdx.x * NWAVES + wave, ngw = gridDim.x * NWAVES;
    for (int m = gw; m < M; m += ngw) {
        const f32x4* xr = (const f32x4*)(x + (size_t)m * D) + lane; f32x4 v[8]; float s = 0.f;
#pragma unroll
        for (int j = 0; j < 8; ++j) { v[j] = xr[64 * j]; s += (v[j].x * v[j].x + v[j].y * v[j].y) + (v[j].z * v[j].z + v[j].w * v[j].w); }
        const float rstd = 1.0f / sqrtf(wave_sum(s) * (1.0f / D) + EPS);
        f32x4* o = (f32x4*)(out + (size_t)m * D) + lane;
#pragma unroll
        for (int j = 0; j < 8; ++j) { const f32x4 ww = ((const f32x4*)w)[lane + 64 * j]; o[64 * j] = (f32x4){v[j].x * rstd * ww.x, v[j].y * rstd * ww.y, v[j].z * rstd * ww.z, v[j].w * rstd * ww.w}; }
    }
}

DI void ph_ba(PTab T, int l) {
    const int tid = otid(), lane = tid & 63, wave = __builtin_amdgcn_readfirstlane(tid >> 6), gw = blockIdx.x * NWAVES + wave, ngw = gridDim.x * NWAVES; (void)lane; (void)gw; (void)ngw;
    unsigned char* const ws = wsp(T); (void)ws;
    const bf16* H = (const bf16*)(ws + WS_H); const bf16* Wt = (const bf16*)(ws + WS_WIN) + ((size_t)l * NIN + NPROJ) * D; float* BA = (float*)(ws + WS_BA);
    const int r = lane & 15, g = lane >> 4;
    for (int wt = gw; wt < M / 16; wt += ngw) {
        const bf16* ap = H + (size_t)(wt * 16 + r) * D + 8 * g; const bf16* b0p = Wt + (size_t)r * D + 8 * g; const bf16* b1p = Wt + (size_t)(16 + r) * D + 8 * g;
        f32x4 acc0 = {0.f, 0.f, 0.f, 0.f}, acc1 = {0.f, 0.f, 0.f, 0.f};
#pragma unroll 4
        for (int k0 = 0; k0 < D; k0 += 32) { const bf16x8 a = *(const bf16x8*)(ap + k0), b0 = *(const bf16x8*)(b0p + k0), b1 = *(const bf16x8*)(b1p + k0);
            acc0 = __builtin_amdgcn_mfma_f32_16x16x32_bf16(a, b0, acc0, 0, 0, 0); acc1 = __builtin_amdgcn_mfma_f32_16x16x32_bf16(a, b1, acc1, 0, 0, 0); }
#pragma unroll
        for (int j = 0; j < 4; ++j) { float* o = BA + (size_t)(wt * 16 + 4 * g + j) * 32; o[r] = acc0[j]; o[16 + r] = acc1[j]; }
    }
}

DI void ph_qkvconv_naive(PTab T, int l) {
    const int tid = otid(), lane = tid & 63, wave = __builtin_amdgcn_readfirstlane(tid >> 6), gw = blockIdx.x * NWAVES + wave, ngw = gridDim.x * NWAVES; (void)lane; (void)gw; (void)ngw;
    unsigned char* const ws = wsp(T); (void)ws;
    const bf16* P = (const bf16*)(ws + WS_PROJ); const float* cw = inp(T, I_CQW) + (size_t)l * 4 * 3 * D;
    float* QN = (float*)(ws + WS_BIG2); float* KN = QN + (size_t)M * D; float* VN = KN + (size_t)M * D;
    for (int task = gw; task < M * NH; task += ngw) {
        const int m = task >> 4, hh = task & 15, t = m & (SEQ - 1);
#pragma unroll
        for (int sec = 0; sec < 3; ++sec) {
            const int col = sec * D + hh * HD + 2 * lane; float a0 = 0.f, a1 = 0.f;
#pragma unroll
            for (int j = 0; j < 4; ++j) { const int tt = t - 3 + j; if (tt >= 0) { const unsigned w = *(const unsigned*)(P + (size_t)(m - 3 + j) * NPROJ + col);
                    a0 += cw[(size_t)j * 3 * D + col] * lo16(w); a1 += cw[(size_t)j * 3 * D + col + 1] * hi16(w); } }
            a0 = siluf_(a0); a1 = siluf_(a1);
            float* dst = (sec == 0 ? QN : sec == 1 ? KN : VN) + (size_t)m * D + hh * HD + 2 * lane;
            if (sec < 2) { const float ss = wave_sum(a0 * a0 + a1 * a1); float sc = 1.0f / sqrtf(ss + EPS); if (sec == 0) sc *= 0.08838834764831845f; a0 *= sc; a1 *= sc; }
            dst[0] = a0; dst[1] = a1;
        }
        if (lane == 0) { const float* ba = (const float*)(ws + WS_BA) + (size_t)m * 32;
            ((float*)(ws + WS_BETA))[(size_t)m * 16 + hh] = sigmoidf_(ba[hh]);
            ((float*)(ws + WS_G))[(size_t)m * 16 + hh] = -expf(inp(T, I_ALOG)[l * NH + hh]) * softplusf_(ba[16 + hh] + inp(T, I_DTB)[l * NH + hh]); }
    }
}
DI void ph_gdn_naive(PTab T, LAS unsigned char* lds) {
    const int tid = otid(), unit0 = blockIdx.x, nunits_stride = gridDim.x;
    unsigned char* const ws = wsp(T);
    const float* QN = (const float*)(ws + WS_BIG2); const float* KN = QN + (size_t)M * D; const float* VN = KN + (size_t)M * D;
    const float* BETA = (const float*)(ws + WS_BETA); const float* G = (const float*)(ws + WS_G); float* O = (float*)(ws + WS_O);
    constexpr int TB = 16;
    LAS float* kl = (LAS float*)lds;
    LAS float* ql = kl + TB * 144;
    LAS float* vl = ql + TB * 144;
    LAS float* bl = vl + TB * 128;
    const int j = tid >> 2, p = tid & 3;
    for (int u = unit0; u < BATCH * NH; u += nunits_stride) {
        const int b = u >> 4, hh = u & 15; float S[32];
#pragma unroll
        for (int i = 0; i < 32; ++i) S[i] = 0.f;
        for (int t0 = 0; t0 < SEQ; t0 += TB) {
            __syncthreads();
            for (int e = tid; e < TB * 128; e += NTHREADS) { const int tt = e >> 7, cc = e & 127; const size_t gi = (size_t)(b * SEQ + t0 + tt) * D + hh * HD + cc;
                kl[tt * 144 + (cc >> 5) * 36 + (cc & 31)] = KN[gi]; ql[tt * 144 + (cc >> 5) * 36 + (cc & 31)] = QN[gi]; vl[tt * 128 + cc] = VN[gi]; }
            if (tid < TB) { const size_t gi = (size_t)(b * SEQ + t0 + tid) * 16 + hh; bl[tid * 2] = BETA[gi]; bl[tid * 2 + 1] = expf(G[gi]); }
            __syncthreads();
            for (int tt = 0; tt < TB; ++tt) {
                const float beta = bl[tt * 2], a = bl[tt * 2 + 1]; const LAS float* kp = kl + tt * 144 + p * 36; const LAS float* qp = ql + tt * 144 + p * 36;
                float kk[32]; float d = 0.f;
#pragma unroll
                for (int i = 0; i < 32; ++i) { kk[i] = kp[i]; d += S[i] * kk[i]; }
                d += __shfl_xor(d, 1); d += __shfl_xor(d, 2);
                const float vn = beta * (vl[tt * 128 + j] - a * d); float oo = 0.f;
#pragma unroll
                for (int i = 0; i < 32; ++i) { S[i] = a * S[i] + kk[i] * vn; oo += S[i] * qp[i]; }
                oo += __shfl_xor(oo, 1); oo += __shfl_xor(oo, 2);
                if (p == 0) O[(size_t)(b * SEQ + t0 + tt) * D + hh * HD + j] = oo;
            }
        }
    }
}
template <int WIN> DI void pooled_run(const bf16* P, bf16* PO, int m0, int col) {
    float r0[WIN], r1[WIN], s0 = 0.f, s1 = 0.f; const int t0 = m0 & (SEQ - 1);
#pragma unroll
    for (int j = 0; j < WIN; ++j) { const unsigned w = (t0 - WIN + j >= 0) ? *(const unsigned*)(P + (size_t)(m0 - WIN + j) * NPROJ + col) : 0u; r0[j] = lo16(w); r1[j] = hi16(w); s0 += r0[j]; s1 += r1[j]; }
    for (int base = 0; base < 128; base += WIN) {
        unsigned w[WIN];
#pragma unroll
        for (int j = 0; j < WIN; ++j) w[j] = *(const unsigned*)(P + (size_t)(m0 + base + j) * NPROJ + col);
#pragma unroll
        for (int j = 0; j < WIN; ++j) { const float x0 = lo16(w[j]), x1 = hi16(w[j]); s0 += x0 - r0[j]; s1 += x1 - r1[j]; r0[j] = x0; r1[j] = x1;
            const int t = t0 + base + j; const float inv = frcp((float)((t + 1) < WIN ? (t + 1) : WIN));
            *(unsigned*)(PO + (size_t)(m0 + base + j) * D + col) = pk2(s0 * inv - x0, s1 * inv - x1); }
    }
}
DI void ph_pooled(PTab T) {
    unsigned char* const ws = wsp(T); const bf16* P = (const bf16*)(ws + WS_PROJ) + C_P; bf16* PO = (bf16*)(ws + WS_POOLED);
    const int tid = otid();
    for (int e = blockIdx.x * NTHREADS + tid; e < (M / 128) * (D / 2); e += gridDim.x * NTHREADS) {
        const int c2 = e & 1023, rb = e >> 10, col = 2 * c2, gi = c2 >> 8, m0 = rb * 128;
        if (gi == 0) pooled_run<2>(P, PO, m0, col); else if (gi == 1) pooled_run<4>(P, PO, m0, col); else if (gi == 2) pooled_run<8>(P, PO, m0, col); else pooled_run<16>(P, PO, m0, col);
    }
}
DI void ph_mix(PTab T, int l) {
    const int tid = otid(); unsigned char* const ws = wsp(T);
    const bf16* P = (const bf16*)(ws + WS_PROJ); const bf16* Y = (const bf16*)(ws + WS_O); const float* SSO = (const float*)(ws + WS_G); const bf16* YB = (const bf16*)(ws + WS_YB); bf16* MX = (bf16*)(ws + WS_MIXED);
    const float* gnw = inp(T, I_GNW) + l * HD; const float* ps = inp(T, I_PS) + l * D;
    for (int e = blockIdx.x * NTHREADS + tid; e < M * (D / 8); e += gridDim.x * NTHREADS) {
        const int m = e >> 8, cb = e & 255, col = 8 * cb, hh = cb >> 4;
        const v4u o = *(const v4u*)(Y + (size_t)m * D + col), z = *(const v4u*)(P + (size_t)m * NPROJ + C_Z + col), ga = *(const v4u*)(P + (size_t)m * NPROJ + C_GA + col),
                  gb = *(const v4u*)(P + (size_t)m * NPROJ + C_GB + col), yb = *(const v4u*)(YB + (size_t)m * D + col);
        const float rstd = frsq(SSO[(size_t)m * 16 + hh] * (1.0f / HD) + EPS);
        const f32x4 g0 = *(const f32x4*)(gnw + (col & 127)), g1 = *(const f32x4*)(gnw + (col & 127) + 4), s0 = *(const f32x4*)(ps + col), s1 = *(const f32x4*)(ps + col + 4);
        v4u r;
#pragma unroll
        for (int i = 0; i < 4; ++i) { const float gl = (i < 2) ? g0[2 * i] : g1[2 * i - 4], gh = (i < 2) ? g0[2 * i + 1] : g1[2 * i - 3], sl = (i < 2) ? s0[2 * i] : s1[2 * i - 4], sh = (i < 2) ? s0[2 * i + 1] : s1[2 * i - 3];
            const float a = fsigmoid(lo16(ga[i])) * (lo16(o[i]) * rstd * gl * fsilu(lo16(z[i]))) + fsigmoid(lo16(gb[i])) * lo16(yb[i]) * sl;
            const float c = fsigmoid(hi16(ga[i])) * (hi16(o[i]) * rstd * gh * fsilu(hi16(z[i]))) + fsigmoid(hi16(gb[i])) * hi16(yb[i]) * sh;
            r[i] = pk2(a, c); }
        *(v4u*)(MX + (size_t)m * D + col) = r;
    }
}
DI void ph_glu_fix(PTab T, int l) {
    unsigned char* const ws = wsp(T); const float* edge = (const float*)(ws + WS_EDGE); bf16* ACT = (bf16*)(ws + WS_BIG2);
    const float* cw = inp(T, I_CFW) + (size_t)l * 3 * DFF; const float* cb = inp(T, I_CFB) + (size_t)l * DFF;
    const int tid = otid();
    for (int e = blockIdx.x * NTHREADS + tid; e < 64 * DFF; e += gridDim.x * NTHREADS) {
        const int pm = e / DFF, f = e % DFF; if ((pm & 15) == 0) continue;
        const float gm2 = edge[((size_t)((0 * 64 + pm - 1) * 2 + 0)) * DFF + f], gm1 = edge[((size_t)((0 * 64 + pm - 1) * 2 + 1)) * DFF + f];
        const float g0 = edge[((size_t)((1 * 64 + pm) * 2 + 0)) * DFF + f], g1 = edge[((size_t)((1 * 64 + pm) * 2 + 1)) * DFF + f];
        const float u0 = edge[((size_t)((2 * 64 + pm) * 2 + 0)) * DFF + f], u1 = edge[((size_t)((2 * 64 + pm) * 2 + 1)) * DFF + f];
        const float w0 = cw[f], w1 = cw[DFF + f], w2 = cw[2 * DFF + f], bb = cb[f];
        ACT[(size_t)(pm * 256) * DFF + f] = (bf16)f2bf(gelu_erf(w0 * gm2 + w1 * gm1 + w2 * g0 + bb) * u0);
        ACT[(size_t)(pm * 256 + 1) * DFF + f] = (bf16)f2bf(gelu_erf(w0 * gm1 + w1 * g0 + w2 * g1 + bb) * u1);
    }
}
typedef float f32x16 __attribute__((ext_vector_type(16)));
typedef __bf16 bf16x2_t __attribute__((ext_vector_type(2)));
DI unsigned cvtpk(float lo, float hi) { const f32x2_t v = {lo, hi}; const bf16x2_t b = __builtin_convertvector(v, bf16x2_t); return __builtin_bit_cast(unsigned, b); }
DI bf16x8 mk8(float a0, float a1, float a2, float a3, float a4, float a5, float a6, float a7) { v4u p; p.x = cvtpk(a0, a1); p.y = cvtpk(a2, a3); p.z = cvtpk(a4, a5); p.w = cvtpk(a6, a7); return __builtin_bit_cast(bf16x8, p); }
#define MFMA32(a, b, c) __builtin_amdgcn_mfma_f32_32x32x16_bf16((a), (b), (c), 0, 0, 0)
#define PACK_STEP(x, s) mk8((x)[8 * (s)], (x)[8 * (s) + 1], (x)[8 * (s) + 2], (x)[8 * (s) + 3], (x)[8 * (s) + 4], (x)[8 * (s) + 5], (x)[8 * (s) + 6], (x)[8 * (s) + 7])
DI f32x16 zero16() { f32x16 z; for (int i = 0; i < 16; ++i) z[i] = 0.f; return z; }
DI bf16x8 frag_row(const LAS float* p) { const f32x4 a = *(const LAS f32x4*)p, b = *(const LAS f32x4*)(p + 4); return mk8(a.x, a.y, a.z, a.w, b.x, b.y, b.z, b.w); }
DI bf16x8 frag_row_s(const LAS float* p, const LAS float* f) { const f32x4 a = *(const LAS f32x4*)p, b = *(const LAS f32x4*)(p + 4), fa = *(const LAS f32x4*)f, fb = *(const LAS f32x4*)(f + 4);
    return mk8(a.x * fa.x, a.y * fa.y, a.z * fa.z, a.w * fa.w, b.x * fb.x, b.y * fb.y, b.z * fb.z, b.w * fb.w); }
DI bf16x8 frag_col(const LAS float* p, int stride) { return mk8(p[0], p[stride], p[2 * stride], p[3 * stride], p[4 * stride], p[5 * stride], p[6 * stride], p[7 * stride]); }

constexpr int OFF_WT = 0, OFF_QDT = 16384, OFF_KE = 32768, OFF_ATT = 49152, OFF_U = 55296, MAIN_BYTES = 49152, ATT_BYTES = 6144, UNIT_BYTES = 71680;
constexpr int NUNITS = BATCH * NH * (SEQ / 64);
static_assert((size_t)NUNITS * UNIT_BYTES <= 384 * MiB, "gdn image fits its region");
constexpr int QS = 132, LS = 68;
constexpr int L_QN = 0, L_KN = 64 * QS * 4, L_VN = 2 * 64 * QS * 4, L_LM = 3 * 64 * QS * 4, L_TM = L_LM + 64 * LS * 4, L_VEC = L_TM + 64 * LS * 4;
static_assert(L_VEC + 5 * 256 <= 161792, "chunk-local LDS map");

#define LDS_BAR() do { asm volatile("s_waitcnt lgkmcnt(0)" ::: "memory"); __builtin_amdgcn_s_barrier(); asm volatile("" ::: "memory"); } while (0)
struct ChunkIn { unsigned raw[3][11]; float b_raw, a_raw; };
DI void gdn_chunk_load(PTab T, int unit, ChunkIn& in, int lane, int w) {
    unsigned char* const ws = wsp(T);
    const int bh = unit >> 6, n = unit & 63, b = bh >> 4, hh = bh & 15, m0 = b * SEQ + n * 64;
    const bf16* P = (const bf16*)(ws + WS_PROJ) + (size_t)hh * HD + 2 * lane;
#pragma unroll
    for (int sec = 0; sec < 3; ++sec)
#pragma unroll
        for (int i = 0; i < 11; ++i) { const int rr = 8 * w - 3 + i; in.raw[sec][i] = (n * 64 + rr >= 0) ? *(const unsigned*)(P + (size_t)(m0 + rr) * NPROJ + sec * D) : 0u; }
    if (w == 0) { const float* ba = (const float*)(ws + WS_BA) + (size_t)(m0 + lane) * 32; in.b_raw = ba[hh]; in.a_raw = ba[16 + hh]; } else { in.b_raw = 0.f; in.a_raw = 0.f; }
}
DI void gdn_chunk_unit(PTab T, int l, LAS unsigned char* lds, int unit, int next_unit, ChunkIn& in) {
    const int tid = otid(), lane = tid & 63, w = __builtin_amdgcn_readfirstlane(tid >> 6), c = lane & 31, h = lane >> 5;
    unsigned char* const ws = wsp(T);
    const int bh = unit >> 6, hh = bh & 15;
    LAS float* QN = (LAS float*)(lds + L_QN); LAS float* KN = (LAS float*)(lds + L_KN); LAS float* VN = (LAS float*)(lds + L_VN);
    LAS float* LM = (LAS float*)(lds + L_LM); LAS float* TM = (LAS float*)(lds + L_TM);
    LAS float* VG = (LAS float*)(lds + L_VEC); LAS float* VBETA = VG + 64; LAS float* VEG = VG + 128; LAS float* VEKE = VG + 192; LAS float* VBEG = VG + 256;
    unsigned char* const ub = ws + WS_BIG2 + (size_t)unit * UNIT_BYTES;
    {
        const float* cw = inp(T, I_CQW) + (size_t)l * 4 * 3 * D + hh * HD + 2 * lane;
#pragma unroll
        for (int sec = 0; sec < 3; ++sec) {
            float w0[4], w1[4];
#pragma unroll
            for (int j = 0; j < 4; ++j) { w0[j] = cw[(size_t)j * 3 * D + sec * D]; w1[j] = cw[(size_t)j * 3 * D + sec * D + 1]; }
            LAS float* dst = (sec == 0 ? QN : sec == 1 ? KN : VN) + 2 * lane;
#pragma unroll
            for (int r = 0; r < 8; ++r) {
                float a0 = 0.f, a1 = 0.f;
#pragma unroll
                for (int j = 0; j < 4; ++j) { a0 += w0[j] * lo16(in.raw[sec][r + j]); a1 += w1[j] * hi16(in.raw[sec][r + j]); }
                a0 = fsilu(a0); a1 = fsilu(a1);
                if (sec < 2) { const float ss = wave_sum(a0 * a0 + a1 * a1); float sc = frsq(ss + EPS); if (sec == 0) sc *= 0.08838834764831845f; a0 *= sc; a1 *= sc; }
                *(LAS f32x2_t*)(dst + (8 * w + r) * QS) = (f32x2_t){a0, a1};
            }
        }
        if (w == 0) {
            const float beta = sigmoidf_(in.b_raw); const float g = -expf(inp(T, I_ALOG)[l * NH + hh]) * softplusf_(in.a_raw + inp(T, I_DTB)[l * NH + hh]);
            float G = g;
#pragma unroll
            for (int o = 1; o < 64; o <<= 1) { const float t = __shfl_up(G, o); if (lane >= o) G += t; }
            const float G63 = __shfl(G, 63); const float eg = expf(G);
            VG[lane] = G; VBETA[lane] = beta; VEG[lane] = eg; VEKE[lane] = expf(G63 - G); VBEG[lane] = beta * eg;
            if (lane == 63) ((float*)(ws + WS_BETA))[unit] = eg;
        }
        if (next_unit >= 0) gdn_chunk_load(T, next_unit, in, lane, w);
    }
    LDS_BAR();
    if (w < 3) {
        const int ti = (w == 0) ? 0 : 1, tj = (w == 2) ? 1 : 0;
        f32x16 acc = zero16();
#pragma unroll
        for (int ks = 0; ks < 8; ++ks) acc = MFMA32(frag_row(KN + (32 * ti + c) * QS + 16 * ks + 8 * h), frag_row(KN + (32 * tj + c) * QS + 16 * ks + 8 * h), acc);
        const int jp = 32 * tj + c; const float Gj = VG[jp];
#pragma unroll
        for (int g4 = 0; g4 < 4; ++g4) { const int ip0 = 32 * ti + 8 * g4 + 4 * h; const f32x4 Gi = *(const LAS f32x4*)(VG + ip0), Bi = *(const LAS f32x4*)(VBETA + ip0);
#pragma unroll
            for (int q = 0; q < 4; ++q) { const int ip = ip0 + q; LM[ip * LS + jp] = (ip > jp) ? Bi[q] * acc[4 * g4 + q] * fexp(Gi[q] - Gj) : 0.f; } }
    }
    LDS_BAR();
    if (w == 0) {
        const int blk = h; const LAS float* Lp = LM + (32 * blk) * LS + 32 * blk; float t[32];
#pragma unroll
        for (int ii = 0; ii < 32; ++ii) {
            float a = (c == ii) ? 1.f : 0.f;
#pragma unroll
            for (int j4 = 0; j4 < (ii + 3) / 4; ++j4) { const f32x4 lv = *(const LAS f32x4*)(Lp + ii * LS + 4 * j4);
#pragma unroll
                for (int q = 0; q < 4; ++q) if (4 * j4 + q < ii) a -= lv[q] * t[4 * j4 + q]; }
            t[ii] = a;
        }
#pragma unroll
        for (int ii = 0; ii < 32; ++ii) TM[(32 * blk + ii) * LS + 32 * blk + c] = t[ii];
        asm volatile("s_waitcnt lgkmcnt(0)" ::: "memory");
        f32x16 x = zero16();
#pragma unroll
        for (int ks = 0; ks < 2; ++ks) x = MFMA32(frag_row(LM + (32 + c) * LS + 16 * ks + 8 * h), frag_col(TM + (16 * ks + 8 * h) * LS + c, LS), x);
        f32x16 y = zero16();
#pragma unroll
        for (int s = 0; s < 2; ++s) { const LAS float* tp = TM + (32 + c) * LS + 32 + 16 * s + 4 * h; const f32x4 a = *(const LAS f32x4*)tp, bq = *(const LAS f32x4*)(tp + 8);
            y = MFMA32(mk8(a.x, a.y, a.z, a.w, bq.x, bq.y, bq.z, bq.w), PACK_STEP(x, s), y); }
#pragma unroll
        for (int g4 = 0; g4 < 4; ++g4)
#pragma unroll
            for (int q = 0; q < 4; ++q) TM[(32 + 8 * g4 + 4 * h + q) * LS + c] = -y[4 * g4 + q];
    } else if (w < 4) {
        const int tj = (w == 3) ? 1 : 0, ti = (w == 1) ? 0 : 1, t3 = w - 1;
        f32x16 acc = zero16();
#pragma unroll
        for (int ks = 0; ks < 8; ++ks) acc = MFMA32(frag_row(KN + (32 * tj + c) * QS + 16 * ks + 8 * h), frag_row(QN + (32 * ti + c) * QS + 16 * ks + 8 * h), acc);
        const int ip = 32 * ti + c; const float Gi = VG[ip];
#pragma unroll
        for (int g4 = 0; g4 < 4; ++g4) { const int jp0 = 32 * tj + 8 * g4 + 4 * h; const f32x4 Gj = *(const LAS f32x4*)(VG + jp0);
#pragma unroll
            for (int q = 0; q < 4; ++q) acc[4 * g4 + q] = (ip >= jp0 + q) ? acc[4 * g4 + q] * fexp(Gi - Gj[q]) : 0.f; }
        *(bf16x8*)(ub + OFF_ATT + (t3 * 2 + 0) * 1024 + lane * 16) = PACK_STEP(acc, 0);
        *(bf16x8*)(ub + OFF_ATT + (t3 * 2 + 1) * 1024 + lane * 16) = PACK_STEP(acc, 1);
    } else if (w < 6) {
        const int ti = w - 4; const float e = VEG[32 * ti + c];
#pragma unroll
        for (int d = 0; d < 4; ++d)
#pragma unroll
            for (int s = 0; s < 2; ++s) { const LAS float* p = QN + (32 * ti + c) * QS + 32 * d + 16 * s + 4 * h; const f32x4 a = *(const LAS f32x4*)p, bq = *(const LAS f32x4*)(p + 8);
                *(bf16x8*)(ub + OFF_QDT + ((d * 2 + ti) * 2 + s) * 1024 + lane * 16) = mk8(a.x * e, a.y * e, a.z * e, a.w * e, bq.x * e, bq.y * e, bq.z * e, bq.w * e); }
    } else {
        const int tj = w - 6;
#pragma unroll
        for (int s = 0; s < 2; ++s) { const int tok0 = 32 * tj + 16 * s + 4 * h; const f32x4 fa = *(const LAS f32x4*)(VEKE + tok0), fb = *(const LAS f32x4*)(VEKE + tok0 + 8);
#pragma unroll
            for (int d = 0; d < 4; ++d) { const LAS float* p = KN + tok0 * QS + 32 * d + c;
                *(bf16x8*)(ub + OFF_KE + ((d * 2 + tj) * 2 + s) * 1024 + lane * 16) = mk8(p[0] * fa.x, p[QS] * fa.y, p[2 * QS] * fa.z, p[3 * QS] * fa.w, p[8 * QS] * fb.x, p[9 * QS] * fb.y, p[10 * QS] * fb.z, p[11 * QS] * fb.w); } }
    }
    LDS_BAR();
    {
        const int d = w >> 1, ti = w & 1; f32x16 acc = zero16();
#pragma unroll
        for (int ks = 0; ks < 4; ++ks) if (ks < 2 || ti == 1)
            acc = MFMA32(frag_col(KN + (16 * ks + 8 * h) * QS + 32 * d + c, QS), frag_row_s(TM + (32 * ti + c) * LS + 16 * ks + 8 * h, VBEG + 16 * ks + 8 * h), acc);
#pragma unroll
        for (int i = 0; i < 16; ++i) acc[i] = -acc[i];
        *(bf16x8*)(ub + OFF_WT + ((d * 2 + ti) * 2 + 0) * 1024 + lane * 16) = PACK_STEP(acc, 0);
        *(bf16x8*)(ub + OFF_WT + ((d * 2 + ti) * 2 + 1) * 1024 + lane * 16) = PACK_STEP(acc, 1);
    }
    {
        const int vt = w >> 1, ti = 1 - (w & 1); f32x16 acc = zero16();
#pragma unroll
        for (int ks = 0; ks < 4; ++ks) if (ks < 2 || ti == 1)
            acc = MFMA32(frag_row_s(TM + (32 * ti + c) * LS + 16 * ks + 8 * h, VBETA + 16 * ks + 8 * h), frag_col(VN + (16 * ks + 8 * h) * QS + 32 * vt + c, QS), acc);
        *(bf16x8*)(ub + OFF_U + ((ti * 4 + vt) * 2 + 0) * 1024 + lane * 16) = PACK_STEP(acc, 0);
        *(bf16x8*)(ub + OFF_U + ((ti * 4 + vt) * 2 + 1) * 1024 + lane * 16) = PACK_STEP(acc, 1);
    }
    LDS_BAR();
}
DI void ph_gdn_chunks(PTab T, int l, LAS unsigned char* lds) {
    const int per = NUNITS / gridDim.x, u0 = blockIdx.x * per, u1 = (blockIdx.x == gridDim.x - 1) ? NUNITS : u0 + per;
    const int tid = otid(), lane = tid & 63, w = __builtin_amdgcn_readfirstlane(tid >> 6);
    ChunkIn in; if (u0 < u1) gdn_chunk_load(T, u0, in, lane, w);
    for (int unit = u0; unit < u1; ++unit) gdn_chunk_unit(T, l, lds, unit, unit + 1 < u1 ? unit + 1 : -1, in);
}

constexpr int SC_ATT = 3 * MAIN_BYTES, SC_SSX = SC_ATT + 2 * ATT_BYTES, SC_END = SC_SSX + 2048;
#define SCAN_BAR() do { asm volatile("" ::: "memory"); __builtin_amdgcn_s_barrier(); asm volatile("" ::: "memory"); } while (0)
DI f32x16 unpack16(const bf16x8 a, const bf16x8 b) {
    const v4u ua = __builtin_bit_cast(v4u, a), ub = __builtin_bit_cast(v4u, b); f32x16 r;
#pragma unroll
    for (int i = 0; i < 4; ++i) { r[2 * i] = lo16(ua[i]); r[2 * i + 1] = hi16(ua[i]); r[8 + 2 * i] = lo16(ub[i]); r[8 + 2 * i + 1] = hi16(ub[i]); }
    return r;
}
DI void ph_gdn_scan(PTab T, LAS unsigned char* lds, int bh) {
    const int tid = otid(), lane = tid & 63, w = __builtin_amdgcn_readfirstlane(tid >> 6), c = lane & 31, h = lane >> 5;
    unsigned char* const ws = wsp(T);
    const unsigned char* const gb = ws + WS_BIG2 + (size_t)bh * 64 * UNIT_BYTES;
    const int b = bh >> 4, hh = bh & 15;
    if (w >= 4) {
        const int lw = w - 4;
        float* const sso = (float*)(ws + WS_G) + (size_t)(b * SEQ) * 16 + hh;
#define DMA_MAIN(nn) do { const unsigned char* src_ = gb + (size_t)(nn) * UNIT_BYTES; LAS unsigned char* dst_ = lds + ((nn) % 3) * MAIN_BYTES; \
        _Pragma("unroll") for (int f_ = 0; f_ < 12; ++f_) __builtin_amdgcn_global_load_lds((const unsigned*)(src_ + (lw + 4 * f_) * 1024 + lane * 16), (LAS unsigned*)(dst_ + (lw + 4 * f_) * 1024), 16, 0, 0); } while (0)
#define DMA_ATT(nn) do { const unsigned char* src_ = gb + (size_t)(nn) * UNIT_BYTES + OFF_ATT; LAS unsigned char* dst_ = lds + SC_ATT + ((nn) & 1) * ATT_BYTES; \
        for (int f_ = lw; f_ < 6; f_ += 4) __builtin_amdgcn_global_load_lds((const unsigned*)(src_ + f_ * 1024 + lane * 16), (LAS unsigned*)(dst_ + f_ * 1024), 16, 0, 0); } while (0)
        DMA_ATT(0); DMA_MAIN(0); DMA_MAIN(1);
        asm volatile("s_waitcnt vmcnt(12)" ::: "memory"); SCAN_BAR();
        for (int n = 0; n < 64; ++n) {
            if (n + 1 < 64) DMA_ATT(n + 1);
            if (n + 2 < 64) { DMA_MAIN(n + 2); }
            if (n > 0 && lw == 0) {
                const LAS float* sx = (const LAS float*)(lds + SC_SSX + ((n - 1) & 1) * 1024);
                sso[(size_t)((n - 1) * 64 + lane) * 16] = (sx[lane] + sx[64 + lane]) + (sx[128 + lane] + sx[192 + lane]);
            }
            if (n + 2 < 64) asm volatile("s_waitcnt vmcnt(12) lgkmcnt(0)" ::: "memory"); else asm volatile("s_waitcnt vmcnt(0) lgkmcnt(0)" ::: "memory");
            SCAN_BAR();
        }
        if (lw == 0) { const LAS float* sx = (const LAS float*)(lds + SC_SSX + (63 & 1) * 1024); sso[(size_t)(63 * 64 + lane) * 16] = (sx[lane] + sx[64 + lane]) + (sx[128 + lane] + sx[192 + lane]); }
#undef DMA_MAIN
#undef DMA_ATT
        return;
    }
    const float decv = ((const float*)(ws + WS_BETA))[bh * 64 + lane];
    bf16* const Yb = (bf16*)(ws + WS_O) + (size_t)(b * SEQ + c) * D + hh * HD + 32 * w + 4 * h;
    const unsigned char* const ubase = gb + OFF_U + (w * 2) * 1024 + lane * 16;
    f32x16 S[4], P0, P1;
#pragma unroll
    for (int d = 0; d < 4; ++d) S[d] = zero16();
    { const bf16x8 a0 = *(const bf16x8*)(ubase), a1 = *(const bf16x8*)(ubase + 1024), b0 = *(const bf16x8*)(ubase + 8192), b1 = *(const bf16x8*)(ubase + 8192 + 1024);
      P0 = unpack16(a0, a1); P1 = unpack16(b0, b1); }
    asm volatile("s_waitcnt vmcnt(0)" ::: "memory"); SCAN_BAR();
    for (int n = 0; n < 64; ++n) {
        const LAS unsigned char* buf = lds + (n % 3) * MAIN_BYTES; const LAS unsigned char* abuf = lds + SC_ATT + (n & 1) * ATT_BYTES;
        const float dec0 = __shfl(decv, n);
        const int nn = (n + 1 < 64) ? n + 1 : n;
        const bf16x8 ua0 = *(const bf16x8*)(ubase + (size_t)nn * UNIT_BYTES), ua1 = *(const bf16x8*)(ubase + (size_t)nn * UNIT_BYTES + 1024),
                     ub0 = *(const bf16x8*)(ubase + (size_t)nn * UNIT_BYTES + 8192), ub1 = *(const bf16x8*)(ubase + (size_t)nn * UNIT_BYTES + 8192 + 1024);
        f32x16 O0 = zero16(), O1 = zero16();
#define FR(off, idx) (*(const LAS bf16x8*)(buf + (off) + (idx) * 1024 + lane * 16))
#define FA(idx) (*(const LAS bf16x8*)(abuf + (idx) * 1024 + lane * 16))
#pragma unroll
        for (int d = 0; d < 4; ++d)
#pragma unroll
            for (int s = 0; s < 2; ++s) { const bf16x8 sb = PACK_STEP(S[d], s);
                P0 = MFMA32(FR(OFF_WT, (d * 2 + 0) * 2 + s), sb, P0); P1 = MFMA32(FR(OFF_WT, (d * 2 + 1) * 2 + s), sb, P1);
                O0 = MFMA32(sb, FR(OFF_QDT, (d * 2 + 0) * 2 + s), O0); O1 = MFMA32(sb, FR(OFF_QDT, (d * 2 + 1) * 2 + s), O1); asm volatile("" ::: "memory"); }
        float dec = dec0; asm volatile("" : "+v"(dec) : "v"(P0[15]), "v"(P1[15]));
        const bf16x8 v00 = PACK_STEP(P0, 0), v01 = PACK_STEP(P0, 1), v10 = PACK_STEP(P1, 0), v11 = PACK_STEP(P1, 1);
#pragma unroll
        for (int d = 0; d < 4; ++d) {
#pragma unroll
            for (int i = 0; i < 16; ++i) S[d][i] *= dec;
            S[d] = MFMA32(FR(OFF_KE, (d * 2 + 0) * 2 + 0), v00, S[d]); S[d] = MFMA32(FR(OFF_KE, (d * 2 + 0) * 2 + 1), v01, S[d]);
            S[d] = MFMA32(FR(OFF_KE, (d * 2 + 1) * 2 + 0), v10, S[d]); S[d] = MFMA32(FR(OFF_KE, (d * 2 + 1) * 2 + 1), v11, S[d]);
            asm volatile("" ::: "memory");
        }
        O0 = MFMA32(v00, FA(0), O0); O0 = MFMA32(v01, FA(1), O0);
        O1 = MFMA32(v00, FA(2), O1); O1 = MFMA32(v01, FA(3), O1);
        O1 = MFMA32(v10, FA(4), O1); O1 = MFMA32(v11, FA(5), O1);
#undef FR
#undef FA
        { float q0 = 0.f, q1 = 0.f;
#pragma unroll
          for (int i = 0; i < 16; ++i) { q0 += O0[i] * O0[i]; q1 += O1[i] * O1[i]; }
          q0 += __shfl_xor(q0, 32); q1 += __shfl_xor(q1, 32);
          ((LAS float*)(lds + SC_SSX + (n & 1) * 1024))[w * 64 + lane] = h ? q1 : q0; }
        { bf16* y0 = Yb + (size_t)(n * 64) * D;
#pragma unroll
          for (int g4 = 0; g4 < 4; ++g4) { v2u a, bq; a.x = cvtpk(O0[4 * g4], O0[4 * g4 + 1]); a.y = cvtpk(O0[4 * g4 + 2], O0[4 * g4 + 3]); bq.x = cvtpk(O1[4 * g4], O1[4 * g4 + 1]); bq.y = cvtpk(O1[4 * g4 + 2], O1[4 * g4 + 3]);
              *(v2u*)(y0 + 8 * g4) = a; *(v2u*)(y0 + (size_t)32 * D + 8 * g4) = bq; } }
        P0 = unpack16(ua0, ua1); P1 = unpack16(ub0, ub1);
        asm volatile("s_waitcnt lgkmcnt(0)" ::: "memory"); SCAN_BAR();
    }
}
#define XB_TMO      128
#define XB_XCNT(j)  (256  + 64 * (j))
#define XB_XSUB(j)  (1280 + 64 * (j))
#define XB_XGEN(j)  (2304 + 64 * (j))
#define XB_TOP      3328
#define XB_TOPGEN   3392
#define XCD_BAR_WORDS 3456
#define XB_SPIN_CAP (1u << 18)

__device__ __forceinline__ unsigned xb_ld(unsigned* p)              { return __hip_atomic_load(p, __ATOMIC_RELAXED, __HIP_MEMORY_SCOPE_AGENT); }
__device__ __forceinline__ unsigned xb_add(unsigned* p, unsigned v) { return __hip_atomic_fetch_add(p, v, __ATOMIC_RELAXED, __HIP_MEMORY_SCOPE_AGENT); }
__device__ __forceinline__ unsigned xb_xcc_id() { return (unsigned)__builtin_amdgcn_s_getreg((3 << 11) | 20) & 0xFu; }
#define XB_SPIN(cond, bar) do { unsigned _sp = 0; while (cond) { __builtin_amdgcn_s_sleep(1); \
    if ((++_sp & 255u) == 0u) { if (xb_ld(&(bar)[XB_TMO])) break; if (_sp > XB_SPIN_CAP) { atomicAdd(&(bar)[XB_TMO], 1u); break; } } } } while (0)

struct XcdBarrier {
    unsigned* bar; unsigned x;
    volatile LAS unsigned* st;
};

__device__ __forceinline__ XcdBarrier xcd_barrier_post(unsigned* bar, volatile LAS unsigned* st) {
    XcdBarrier b; b.bar = bar; b.x = xb_xcc_id(); b.st = st;
    if (threadIdx.x == 0) (void)xb_add(&bar[XB_XCNT(b.x)], 1u);
    return b;
}
__device__ __forceinline__ void xcd_barrier_complete(unsigned* bar, unsigned x, unsigned& nloc, unsigned& nx) {
    const unsigned G = gridDim.x * gridDim.y * gridDim.z;
    unsigned sum, cnt, mine, sp = 0u;
    for (;;) {
        sum = 0u; cnt = 0u; mine = 0u;
#pragma unroll
        for (unsigned j = 0; j < 16; ++j) { const unsigned c = xb_ld(&bar[XB_XCNT(j)]); sum += c; cnt += (c > 0u) ? 1u : 0u; mine = (j == x) ? c : mine; }
        if (sum == G) break;
        __builtin_amdgcn_s_sleep(1);
        if ((++sp & 255u) == 0u) { if (xb_ld(&bar[XB_TMO])) break; if (sp > XB_SPIN_CAP) { atomicAdd(&bar[XB_TMO], 1u); break; } }
    }
    nloc = mine > 0u ? mine : 1u; nx = cnt > 0u ? cnt : 1u;
}

__device__ __forceinline__ void xcd_barrier(const XcdBarrier& b) {
    asm volatile("s_waitcnt vmcnt(0)" ::: "memory");
    __syncthreads();
    if (threadIdx.x == 0) {
        unsigned* bar = b.bar;
        __builtin_amdgcn_s_waitcnt(0);
        unsigned nloc = b.st[0], nx = b.st[1];
        if (nloc == 0u) { xcd_barrier_complete(bar, b.x, nloc, nx); b.st[0] = nloc; b.st[1] = nx; }
        const unsigned old = xb_add(&bar[XB_XSUB(b.x)], 1u);
        const unsigned gen = old / nloc;
        if (old + 1u == (gen + 1u) * nloc) {
            __builtin_amdgcn_fence(__ATOMIC_RELEASE, "agent");
            asm volatile("s_waitcnt vmcnt(0)" ::: "memory");
            const unsigned og = xb_add(&bar[XB_TOP], 1u);
            const unsigned tg = og / nx;
            if (og + 1u == (tg + 1u) * nx) xb_add(&bar[XB_TOPGEN], 1u);
            else XB_SPIN(xb_ld(&bar[XB_TOPGEN]) == tg, bar);
            __builtin_amdgcn_fence(__ATOMIC_ACQUIRE, "agent");
            xb_add(&bar[XB_XGEN(b.x)], 1u);
            asm volatile("s_waitcnt vmcnt(0)" ::: "memory");
        } else {
            XB_SPIN(xb_ld(&bar[XB_XGEN(b.x)]) == gen, bar);
            __builtin_amdgcn_fence(__ATOMIC_ACQUIRE, "agent");
            asm volatile("s_waitcnt vmcnt(0)" ::: "memory");
        }
    }
    __syncthreads();
}
constexpr int RING_BYTES = 131072;
constexpr int MISC_OFF = 161792;
constexpr int LDS_BYTES = 162816;
constexpr int CW_BAR = 4096;
constexpr size_t CTL_ZERO_BYTES = 1 * MiB;

#ifndef REP_EW
#define REP_EW 1
#endif
#ifndef REP_CHUNK
#define REP_CHUNK 1
#endif
#ifndef REP_SCAN
#define REP_SCAN 1
#endif
#ifndef REP_CONV
#define REP_CONV 1
#endif
#define GRID_BAR() xcd_barrier(bar)
#define WSB(off) ((bf16*)(wsp(T) + (off)))
#define OPQ(x) opq_s((int)(x))
DI int opq_s(int x) { asm volatile("" : "+s"(x)); return x; }
template <int l> DI void layer_body(PTab T, LAS unsigned char* lds, const XcdBarrier& bar) {
        for (int rep_ = 0; rep_ < REP_EW; ++rep_) {
            ph_rmsnorm_bf16(l == 0 ? inp(T, I_X) : outp(T), inp(T, I_NMW) + l * D, WSB(WS_H));
        }
        GRID_BAR();
        ph_ba(T, l);
        { pg8::Gemm g{WSB(WS_H), WSB(WS_WIN) + (size_t)l * NIN * D, M, NPROJ, D, D, D, 0};
          pg8::StaticOrder S; S.init(M, NPROJ, OPQ(gridDim.x), OPQ(blockIdx.x)); pg8::EpiBf16 E{WSB(WS_PROJ), NPROJ};
          pg8::gemm_phase<pg8::EpiBf16, pg8::StaticOrder, true, true>(lds, g, S, E); }
        GRID_BAR();
        for (int rep_ = 0; rep_ < REP_CHUNK; ++rep_) {
            ph_gdn_chunks(T, l, lds);
        }
        for (int rep_ = 0; rep_ < REP_EW; ++rep_) {
            ph_pooled(T);
        }
        GRID_BAR();
        if (blockIdx.x < BATCH * NH) { for (int rep_ = 0; rep_ < REP_SCAN; ++rep_) { if (rep_) __syncthreads(); ph_gdn_scan(T, lds, blockIdx.x); } }
        else { pg8::Gemm g{WSB(WS_POOLED), WSB(WS_WPL) + (size_t)l * D * 512, M, D, 512, D, 512, 2};
          pg8::StaticOrder S; S.init(M, D, OPQ(gridDim.x) - BATCH * NH, OPQ(blockIdx.x) - BATCH * NH); pg8::EpiBf16 E{WSB(WS_YB), D};
          pg8::gemm_phase<pg8::EpiBf16, pg8::StaticOrder, true, true>(lds, g, S, E); }
        GRID_BAR();
        for (int rep_ = 0; rep_ < REP_EW; ++rep_) {
            ph_mix(T, l);
        }
        GRID_BAR();
        { pg8::Gemm g{WSB(WS_MIXED), WSB(WS_WOUT) + (size_t)l * D * D, M, D, D, D, D, 0};
          pg8::StaticOrder S; S.init(M, D, OPQ(gridDim.x), OPQ(blockIdx.x)); pg8::EpiResF32 E{l == 0 ? inp(T, I_X) : outp(T), outp(T), D};
          pg8::gemm_phase<pg8::EpiResF32, pg8::StaticOrder, true, true>(lds, g, S, E); }
        GRID_BAR();
        for (int rep_ = 0; rep_ < REP_EW; ++rep_) {
            ph_rmsnorm_bf16(outp(T), inp(T, I_NFW) + l * D, WSB(WS_H));
        }
        GRID_BAR();
        { pg8::Gemm g{WSB(WS_H), WSB(WS_WUP) + (size_t)l * 2 * DFF * D, M, 2 * DFF, D, D, D, 0};
          pg8::StaticOrder S; S.init(M, 2 * DFF, OPQ(gridDim.x), OPQ(blockIdx.x));
          pg8::EpiGlu E{WSB(WS_BIG2), inp(T, I_CFW) + (size_t)l * 3 * DFF, inp(T, I_CFB) + (size_t)l * DFF, (float*)(wsp(T) + WS_EDGE), (LAS float*)(lds + RING_BYTES), DFF};
          pg8::gemm_phase<pg8::EpiGlu, pg8::StaticOrder, true, true>(lds, g, S, E); }
        GRID_BAR();
        ph_glu_fix(T, l);
        GRID_BAR();
        { pg8::Gemm g{WSB(WS_BIG2), WSB(WS_WDN) + (size_t)l * D * DFF, M, D, DFF, DFF, DFF, 0};
          pg8::StaticOrder S; S.init(M, D, OPQ(gridDim.x), OPQ(blockIdx.x)); pg8::EpiResF32 E{outp(T), outp(T), D};
          pg8::gemm_phase<pg8::EpiResF32, pg8::StaticOrder, true, true>(lds, g, S, E); }
        GRID_BAR();
}
static_assert(SC_END <= MISC_OFF && L_VEC + 5 * 256 <= MISC_OFF && RING_BYTES + 4096 <= MISC_OFF, "LDS map");
constexpr int TAB_OFF = MISC_OFF + 256;
__global__ void __launch_bounds__(NTHREADS, 2) mega_fwd(Ctx c) {
    extern __shared__ __attribute__((aligned(16))) unsigned char lds_raw[];
    LAS unsigned char* lds = (LAS unsigned char*)lds_raw;
    for (int u = threadIdx.x; u < (LDS_BYTES - MISC_OFF) / 4; u += NTHREADS) ((LAS unsigned*)(lds + MISC_OFF))[u] = 0u;
    __syncthreads();
    if (threadIdx.x < 16) ((LAS unsigned long long*)(lds + TAB_OFF))[threadIdx.x] = (unsigned long long)c.in[threadIdx.x];
    if (threadIdx.x == 16) ((LAS unsigned long long*)(lds + TAB_OFF))[16] = (unsigned long long)c.out;
    if (threadIdx.x == 17) ((LAS unsigned long long*)(lds + TAB_OFF))[17] = (unsigned long long)c.ws;
    __syncthreads();
    const PTab T = (PTab)(lds + TAB_OFF);
    XcdBarrier bar = xcd_barrier_post((unsigned*)(wsp(T) + WS_CTL) + CW_BAR, (volatile LAS unsigned*)(lds + MISC_OFF) + 8);

    for (int rep_ = 0; rep_ < REP_CONV; ++rep_) ph_convert(T, lds);
    GRID_BAR();
    layer_body<0>(T, lds, bar); layer_body<1>(T, lds, bar); layer_body<2>(T, lds, bar); layer_body<3>(T, lds, bar);
    const bool poison = __hip_atomic_load((unsigned*)(wsp(T) + WS_CTL) + CW_BAR + XB_TMO, __ATOMIC_RELAXED, __HIP_MEMORY_SCOPE_AGENT) != 0u;
    ph_rmsnorm_f32(outp(T), inp(T, I_NFIN), outp(T));
    if (poison) { asm volatile("s_waitcnt vmcnt(0)" ::: "memory"); float* X = outp(T); const float q = __builtin_nanf(""); for (size_t e = (size_t)blockIdx.x * NTHREADS + threadIdx.x; e < (size_t)M * D; e += (size_t)gridDim.x * NTHREADS) X[e] = q; }
#undef GRID_BAR
#undef WSB
}

extern "C" void kernel_launch(void* const* d_in, const int* in_sizes, int n_in, void* d_out, int out_size, void* d_ws, size_t ws_size, hipStream_t stream) {
    static int grid = 0;
    if (grid == 0) {
        if (n_in != 16 || out_size != M * D || ws_size < WS_END) { fprintf(stderr, "kernel_launch: unexpected shapes (n_in %d, out %d, ws %zu)\n", n_in, out_size, ws_size); grid = -1; return; }
        int dev = 0, cus = 0, per_cu = 0;
        if (hipGetDevice(&dev) != hipSuccess || hipDeviceGetAttribute(&cus, hipDeviceAttributeMultiprocessorCount, dev) != hipSuccess) { grid = -1; return; }
        if (hipFuncSetAttribute((const void*)mega_fwd, hipFuncAttributeMaxDynamicSharedMemorySize, LDS_BYTES) != hipSuccess) { fprintf(stderr, "kernel_launch: hipFuncSetAttribute failed\n"); grid = -1; return; }
        if (hipOccupancyMaxActiveBlocksPerMultiprocessor(&per_cu, (const void*)mega_fwd, NTHREADS, LDS_BYTES) != hipSuccess || per_cu < 1) fprintf(stderr, "kernel_launch: occupancy query says %d\n", per_cu);
        (void)hipGetLastError();
        grid = cus;
    }
    if (grid < 0) return;
    if (hipMemsetAsync((char*)d_ws + WS_CTL, 0, CTL_ZERO_BYTES, stream) != hipSuccess) return;
    Ctx c{};
    for (int i = 0; i < 16; ++i) c.in[i] = (const float*)d_in[i];
    c.out = (float*)d_out; c.ws = (unsigned char*)d_ws;
    hipLaunchKernelGGL(mega_fwd, dim3(grid), dim3(NTHREADS), LDS_BYTES, stream, c);
}
```

```cpp
#include <hip/hip_runtime.h>
#include <cstdio>
#include <cstdint>

namespace pg8 {
#define PG8_LAS __attribute__((address_space(3)))
typedef unsigned short bf16_t;
typedef short bf16x8 __attribute__((ext_vector_type(8)));
typedef float f32x4 __attribute__((ext_vector_type(4)));
typedef unsigned u32x4 __attribute__((ext_vector_type(4)));
constexpr int BM = 256, BK = 64, HALF = 128, HTB = HALF * BK * 2  , STAGE_BYTES = 8 * HTB, NXCD = 8, WGM = 8;

__host__ __device__ __forceinline__ int lds_byte(int r, int c) { const int st = (r >> 4) * 2 + (c >> 5), rr = r & 15, cc = c & 31, ob = rr * 64 + cc * 2; return st * 1024 + (ob ^ (((ob >> 9) & 1) << 5)); }
__host__ __device__ __forceinline__ void stage_rc(int b, int& R, int& C) { const int st = b / 1024, sb = b % 1024, swz = sb ^ (((sb >> 9) & 1) << 5); R = (st >> 1) * 16 + swz / 64; C = (st & 1) * 32 + (swz % 64) / 2; }
__host__ __device__ __forceinline__ int perm32(int rho) { const int n = rho >> 4, i = rho & 15; return 8 * (i >> 2) + 4 * n + (i & 3); }

struct Unit { int pm, pn; };
struct Gemm { const bf16_t* A; const bf16_t* Bt; int M, N, K, lda, ldb, agrp; };

struct StaticOrder {
    int nM, nN, nwg, G, c;
    __host__ __device__ void init(int M, int N, int G_, int c_) { nM = M / BM; nN = N / BM; nwg = nM * nN; G = G_; c = c_; }
    __host__ __device__ bool next(int i, Unit& u) const {
        const long L = (long)i * G + c; if (L >= nwg) return false;
        int wgid = (int)L; { const int q = nwg / NXCD, r = nwg % NXCD, xcd = wgid % NXCD, off = wgid / NXCD; wgid = (xcd < r ? xcd * (q + 1) : r * (q + 1) + (xcd - r) * q) + off; }
        const int nig = WGM * nN, gid = wgid / nig, fm = gid * WGM, gsz = (nM - fm) < WGM ? (nM - fm) : WGM;
        u.pm = fm + ((wgid % nig) % gsz); u.pn = (wgid % nig) / gsz; return true;
    }
    __device__ __forceinline__ void a_ready(const Unit&) const {}
    __device__ __forceinline__ void done(const Unit&) const {}
};
struct StaticOrderIn : StaticOrder {
    __host__ __device__ bool next(int i, Unit& u) const { const bool r = StaticOrder::next(i, u);
        if (r) { const int s = u.pn; u.pn = s < 16 ? 24 + s : s < 24 ? 32 + s : s < 48 ? s - 24 : s - 8; } return r; }
};

__device__ __forceinline__ unsigned cvt_pk_bf16(float lo, float hi) { unsigned r; asm volatile("v_cvt_pk_bf16_f32 %0, %1, %2" : "=v"(r) : "v"(lo), "v"(hi)); return r; }
typedef float f32x2 __attribute__((ext_vector_type(2)));

struct EpiBf16 {
    static constexpr bool PERM = true, AFTER_DRAIN = false;
    bf16_t* O; int ldc;
    __device__ __forceinline__ void operator()(const f32x4 (&acc)[2][2][4][2], const Unit& u, int wr, int wc, int fr, int fq) const {
        const int row0 = u.pm * BM + wr * 64 + fr; const int col0 = u.pn * BM + wc * 32 + 8 * fq;
#pragma unroll
        for (int ai = 0; ai < 2; ++ai)
#pragma unroll
            for (int m = 0; m < 4; ++m) { bf16_t* rowp = O + (size_t)(row0 + ai * HALF + m * 16) * ldc + col0;
#pragma unroll
                for (int bj = 0; bj < 2; ++bj) { const f32x4 v0 = acc[ai][bj][m][0], v1 = acc[ai][bj][m][1];
                    u32x4 w; w.x = cvt_pk_bf16(v0[0], v0[1]); w.y = cvt_pk_bf16(v0[2], v0[3]); w.z = cvt_pk_bf16(v1[0], v1[1]); w.w = cvt_pk_bf16(v1[2], v1[3]);
                    *(u32x4*)(rowp + bj * HALF) = w; } }
    }
};
struct EpiProj {
    static constexpr bool PERM = true, AFTER_DRAIN = false;
    bf16_t* O; int ldc;
    __device__ __forceinline__ void operator()(const f32x4 (&acc)[2][2][4][2], const Unit& u, int wr, int wc, int fr, int fq) const {
        const int row0 = u.pm * BM + wr * 64 + fr; const int lc = wc * 32 + 8 * fq;
        if (u.pn >= 24 && u.pn < 40) {
            const int col0 = 6144 + 128 * (u.pn - 24) + lc;
#pragma unroll
            for (int ai = 0; ai < 2; ++ai)
#pragma unroll
                for (int m = 0; m < 4; ++m) { u32x4 w;
#pragma unroll
                    for (int n = 0; n < 2; ++n) { const f32x4 z = acc[ai][0][m][n], g = acc[ai][1][m][n]; f32x4 r;
#pragma unroll
                        for (int e = 0; e < 4; ++e) r[e] = z[e] * __builtin_amdgcn_rcpf((1.0f + __builtin_amdgcn_exp2f(-1.4426950408889634f * z[e])) * (1.0f + __builtin_amdgcn_exp2f(-1.4426950408889634f * g[e])));
                        const unsigned lo = cvt_pk_bf16(r[0], r[1]), hi = cvt_pk_bf16(r[2], r[3]); if (n == 0) { w.x = lo; w.y = hi; } else { w.z = lo; w.w = hi; } }
                    *(u32x4*)(O + (size_t)(row0 + ai * HALF + m * 16) * ldc + col0) = w; }
        } else {
            const int col0 = (u.pn < 24 ? 256 * u.pn : 8192 + 256 * (u.pn - 40)) + lc;
#pragma unroll
            for (int ai = 0; ai < 2; ++ai)
#pragma unroll
                for (int m = 0; m < 4; ++m) { bf16_t* rowp = O + (size_t)(row0 + ai * HALF + m * 16) * ldc + col0;
#pragma unroll
                    for (int bj = 0; bj < 2; ++bj) { const f32x4 v0 = acc[ai][bj][m][0], v1 = acc[ai][bj][m][1];
                        u32x4 w; w.x = cvt_pk_bf16(v0[0], v0[1]); w.y = cvt_pk_bf16(v0[2], v0[3]); w.z = cvt_pk_bf16(v1[0], v1[1]); w.w = cvt_pk_bf16(v1[2], v1[3]);
                        *(u32x4*)(rowp + bj * HALF) = w; } }
        }
    }
};
struct EpiPool {
    static constexpr bool PERM = true, AFTER_DRAIN = false;
    bf16_t* O; int ldc; const float* scale; const bf16_t* gate; int ldg;
    __device__ __forceinline__ void operator()(const f32x4 (&acc)[2][2][4][2], const Unit& u, int wr, int wc, int fr, int fq) const {
        const int row0 = u.pm * BM + wr * 64 + fr; const int col0 = u.pn * BM + wc * 32 + 8 * fq;
        f32x4 sc[2][2];
#pragma unroll
        for (int bj = 0; bj < 2; ++bj) { sc[bj][0] = *(const f32x4*)(scale + col0 + bj * HALF); sc[bj][1] = *(const f32x4*)(scale + col0 + bj * HALF + 4); }
#pragma unroll
        for (int ai = 0; ai < 2; ++ai)
#pragma unroll
            for (int m = 0; m < 4; ++m) { const size_t row = (size_t)(row0 + ai * HALF + m * 16); bf16_t* rowp = O + row * ldc + col0;
                u32x4 gt[2];
#pragma unroll
                for (int bj = 0; bj < 2; ++bj) gt[bj] = *(const u32x4*)(gate + row * ldg + col0 + bj * HALF);
#pragma unroll
                for (int bj = 0; bj < 2; ++bj) { f32x4 v0 = acc[ai][bj][m][0] * sc[bj][0], v1 = acc[ai][bj][m][1] * sc[bj][1];
#pragma unroll
                    for (int e = 0; e < 2; ++e) { const float g0 = __uint_as_float(gt[bj][e] << 16), g1 = __uint_as_float(gt[bj][e] & 0xffff0000u), g2 = __uint_as_float(gt[bj][2 + e] << 16), g3 = __uint_as_float(gt[bj][2 + e] & 0xffff0000u);
                        v0[2 * e] *= __builtin_amdgcn_rcpf(1.0f + __builtin_amdgcn_exp2f(-1.4426950408889634f * g0)); v0[2 * e + 1] *= __builtin_amdgcn_rcpf(1.0f + __builtin_amdgcn_exp2f(-1.4426950408889634f * g1));
                        v1[2 * e] *= __builtin_amdgcn_rcpf(1.0f + __builtin_amdgcn_exp2f(-1.4426950408889634f * g2)); v1[2 * e + 1] *= __builtin_amdgcn_rcpf(1.0f + __builtin_amdgcn_exp2f(-1.4426950408889634f * g3)); }
                    u32x4 w; w.x = cvt_pk_bf16(v0[0], v0[1]); w.y = cvt_pk_bf16(v0[2], v0[3]); w.z = cvt_pk_bf16(v1[0], v1[1]); w.w = cvt_pk_bf16(v1[2], v1[3]);
                    *(u32x4*)(rowp + bj * HALF) = w; } }
    }
};
struct EpiResF32 {
    static constexpr bool PERM = false, AFTER_DRAIN = false;
    const float* base; float* out; int ldc;
    __device__ __forceinline__ void operator()(const f32x4 (&acc)[2][2][4][2], const Unit& u, int wr, int wc, int fr, int fq) const {
        const int row0 = u.pm * BM + wr * 64 + fr, col0 = u.pn * BM + wc * 32 + 4 * fq;
#pragma unroll
        for (int ai = 0; ai < 2; ++ai) {
            f32x4 bs[4][2][2];
#pragma unroll
            for (int m = 0; m < 4; ++m) { const size_t off = (size_t)(row0 + ai * HALF + m * 16) * ldc + col0;
#pragma unroll
                for (int bj = 0; bj < 2; ++bj)
#pragma unroll
                    for (int n = 0; n < 2; ++n) bs[m][bj][n] = *(const f32x4*)(base + off + bj * HALF + n * 16); }
#pragma unroll
            for (int m = 0; m < 4; ++m) { const size_t off = (size_t)(row0 + ai * HALF + m * 16) * ldc + col0;
#pragma unroll
                for (int bj = 0; bj < 2; ++bj)
#pragma unroll
                    for (int n = 0; n < 2; ++n) *(f32x4*)(out + off + bj * HALF + n * 16) = bs[m][bj][n] + acc[ai][bj][m][n]; }
            asm volatile("" ::: "memory"); }
    }
};

__device__ __forceinline__ f32x2 gelu_pk(f32x2 v) {
    const f32x2 av = __builtin_elementwise_abs(v), d = av * 0.2316418882f + 1.0f;
    f32x2 t; t.x = __builtin_amdgcn_rcpf(d.x); t.y = __builtin_amdgcn_rcpf(d.y);
    f32x2 q = t * 0.5307027145f + (-0.7265760135f); q = q * t + 0.7107068705f; q = q * t + (-0.142248368f); q = q * t + 0.127414796f; q = q * t;
    const f32x2 s = (v * v) * (-0.72134752044f);
    f32x2 e; e.x = __builtin_amdgcn_exp2f(s.x); e.y = __builtin_amdgcn_exp2f(s.y);
    const f32x2 m = v * (q * e), r = v - m;
    f32x2 o; o.x = v.x < 0.f ? m.x : r.x; o.y = v.y < 0.f ? m.y : r.y; return o;
}
template <int N> __device__ __forceinline__ float row_ror(float x) { return __builtin_bit_cast(float, __builtin_amdgcn_update_dpp(0, __builtin_bit_cast(int, x), 0x120 + N, 0xf, 0xf, false)); }
struct EpiGlu {
    static constexpr bool PERM = true, AFTER_DRAIN = false;
    bf16_t* ACT; const float* cw; const float* cb; float* edge; PG8_LAS float* xb; int dff;
    __device__ __forceinline__ void operator()(const f32x4 (&acc)[2][2][4][2], const Unit& u, int wr, int wc, int fr, int fq) const {
        const int f0 = u.pn * 128 + wc * 32 + 8 * fq;
        if (fr >= 14) {
#pragma unroll
            for (int ai = 0; ai < 2; ++ai) { PG8_LAS f32x4* p = (PG8_LAS f32x4*)(xb + ((((wr * 2 + ai) * 4 + wc) * 2 + (fr - 14)) * 32 + 8 * fq)); p[0] = acc[ai][0][3][0]; p[1] = acc[ai][0][3][1]; }
        }
        asm volatile("s_waitcnt lgkmcnt(0)" ::: "memory"); __builtin_amdgcn_s_barrier(); asm volatile("" ::: "memory");
        f32x4 w0[2], w1[2], w2[2], bb[2];
#pragma unroll
        for (int n = 0; n < 2; ++n) { w0[n] = *(const f32x4*)(cw + f0 + 4 * n); w1[n] = *(const f32x4*)(cw + dff + f0 + 4 * n); w2[n] = *(const f32x4*)(cw + 2 * dff + f0 + 4 * n); bb[n] = *(const f32x4*)(cb + f0 + 4 * n); }
        const bool seq_start = (u.pm & 15) == 0;
#pragma unroll
        for (int ai = 0; ai < 2; ++ai) {
            f32x4 pr1[2], pr2[2];
            if (wr == 1 || ai == 1) { const int swr = (wr == 1) ? 0 : 1, sai = (wr == 1) ? ai : 0; const PG8_LAS f32x4* p = (const PG8_LAS f32x4*)(xb + ((((swr * 2 + sai) * 4 + wc) * 2) * 32 + 8 * fq));
                const f32x4 a0 = p[0], a1 = p[1], b0 = p[8], b1 = p[9]; pr1[0] = b0; pr1[1] = b1; pr2[0] = (fr == 0) ? a0 : b0; pr2[1] = (fr == 0) ? a1 : b1; }
            else { pr1[0] = pr1[1] = pr2[0] = pr2[1] = (f32x4){0.f, 0.f, 0.f, 0.f}; }
            const bool defer_blk = (ai == 0) && (wr == 0) && !seq_start;
#pragma unroll
            for (int m = 0; m < 4; ++m) {
                const int row = u.pm * BM + ai * HALF + wr * 64 + m * 16 + fr; u32x4 w;
#pragma unroll
                for (int n = 0; n < 2; ++n) { const f32x4 g = acc[ai][0][m][n], up = acc[ai][1][m][n]; f32x4 r1, r2, a;
                    r1[0] = row_ror<1>(g[0]); r1[1] = row_ror<1>(g[1]); r1[2] = row_ror<1>(g[2]); r1[3] = row_ror<1>(g[3]);
                    r2[0] = row_ror<2>(g[0]); r2[1] = row_ror<2>(g[1]); r2[2] = row_ror<2>(g[2]); r2[3] = row_ror<2>(g[3]);
#pragma unroll
                    for (int e = 0; e < 4; ++e) { const float p1 = (fr >= 1) ? r1[e] : pr1[n][e], p2 = (fr >= 2) ? r2[e] : pr2[n][e]; a[e] = w0[n][e] * p2 + w1[n][e] * p1 + w2[n][e] * g[e] + bb[n][e]; }
                    pr1[n] = r1; pr2[n] = r2;
                    const f32x2 x0 = gelu_pk((f32x2){a[0], a[1]}), x1 = gelu_pk((f32x2){a[2], a[3]});
                    const unsigned lo = cvt_pk_bf16(x0.x * up[0], x0.y * up[1]), hi = cvt_pk_bf16(x1.x * up[2], x1.y * up[3]);
                    if (n == 0) { w.x = lo; w.y = hi; } else { w.z = lo; w.w = hi; } }
                if (defer_blk && m == 0 && fr < 2) { float* eg = edge + ((size_t)((1 * 64 + u.pm) * 2 + fr)) * dff + f0; float* eu = edge + ((size_t)((2 * 64 + u.pm) * 2 + fr)) * dff + f0;
                    *(f32x4*)eg = acc[0][0][0][0]; *(f32x4*)(eg + 4) = acc[0][0][0][1]; *(f32x4*)eu = acc[0][1][0][0]; *(f32x4*)(eu + 4) = acc[0][1][0][1]; }
                else *(u32x4*)(ACT + (size_t)row * dff + f0) = w;
                if (ai == 1 && wr == 1 && m == 3 && fr >= 14) { float* el = edge + ((size_t)((0 * 64 + u.pm) * 2 + (fr - 14))) * dff + f0; *(f32x4*)el = acc[1][0][3][0]; *(f32x4*)(el + 4) = acc[1][0][3][1]; }
            }
        }
    }
};

template <class Epi, class Sched, bool ALIGN_EPI = false, bool SP2 = false>
__device__ __forceinline__ void gemm_phase(PG8_LAS unsigned char* lds, const Gemm g, const Sched& S, const Epi& E) {
    int tid_ = threadIdx.x; asm volatile("" : "+v"(tid_));
    const int tid = tid_, wid = __builtin_amdgcn_readfirstlane(tid >> 6), lane = tid & 63, wr = wid >> 2, wc = wid & 3, fr = lane & 15, fq = lane >> 4;
    const int K = g.K, nt = K / BK;
    unsigned voffA[2], voffB[2];
#pragma unroll
    for (int i = 0; i < 2; ++i) { int R, C; stage_rc(tid * 16 + i * 8192, R, C); const int Rb = Epi::PERM ? ((R & ~31) + perm32(R & 31)) : R;
        voffA[i] = (unsigned)(R * g.lda + C) * 2u; voffB[i] = (unsigned)(Rb * g.ldb + C) * 2u; }
    const size_t kstep = (size_t)(BK * 2);
    const size_t hsA = (size_t)HALF * g.lda * 2, hsB = (size_t)HALF * g.ldb * 2;
    const size_t tsA = 2 * hsA, tsB = 2 * hsB;
#define PG8_UA(u) ((const char*)g.A + (size_t)(u).pm * tsA + (g.agrp ? (size_t)((u).pn / g.agrp) * (size_t)K * 2 : (size_t)0))
#define PG8_UB(u) ((const char*)g.Bt + (size_t)(u).pn * tsB)
    const unsigned ldsw = (unsigned)wid * 1024u;
    const int aoff = lds_byte(wr * 64 + fr, fq * 8), boff = lds_byte(wc * 32 + fr, fq * 8);
#define PG8_SA(b, h) (((b) * 2 + (h)) * HTB)
#define PG8_SB(b, h) ((4 + (b) * 2 + (h)) * HTB)
#define PG8_STAGE(bufoff, gbase, voff) do { _Pragma("unroll") for (int _i = 0; _i < 2; ++_i) \
        __builtin_amdgcn_global_load_lds((const unsigned*)((const char*)(gbase) + (voff)[_i]), (PG8_LAS unsigned*)(lds + (bufoff) + ldsw + _i * 8192), 16, 0, 0); } while (0)
#define PG8_LDA(dst, b, h) do { _Pragma("unroll") for (int m = 0; m < 4; ++m) _Pragma("unroll") for (int k = 0; k < 2; ++k) dst[m][k] = *(const PG8_LAS bf16x8*)(lds + PG8_SA(b, h) + aoff + m * 2048 + k * 1024); } while (0)
#define PG8_LDB(dst, b, h) do { _Pragma("unroll") for (int n = 0; n < 2; ++n) _Pragma("unroll") for (int k = 0; k < 2; ++k) dst[n][k] = *(const PG8_LAS bf16x8*)(lds + PG8_SB(b, h) + boff + n * 2048 + k * 1024); } while (0)
#define PG8_MMA(ai, bj, At, Bt) do { __builtin_amdgcn_s_setprio(1); _Pragma("unroll") for (int m = 0; m < 4; ++m) _Pragma("unroll") for (int n = 0; n < 2; ++n) _Pragma("unroll") for (int k = 0; k < 2; ++k) \
        acc[ai][bj][m][n] = __builtin_amdgcn_mfma_f32_16x16x32_bf16(Bt[n][k], At[m][k], acc[ai][bj][m][n], 0, 0, 0); __builtin_amdgcn_s_setprio(0); } while (0)
#define PG8_WAIT_V(n) asm volatile("s_waitcnt vmcnt(" #n ")" ::: "memory")
#define PG8_WAIT_L(n) asm volatile("s_waitcnt lgkmcnt(" #n ")" ::: "memory")
#define PG8_BAR __builtin_amdgcn_s_barrier()
#define PG8_SCHED __builtin_amdgcn_sched_barrier(0)
    Unit cur, nxt; int ui = 0;
    if (!S.next(0, cur)) return;
    f32x4 acc[2][2][4][2];
#pragma unroll
    for (int a = 0; a < 2; ++a)
#pragma unroll
        for (int b = 0; b < 2; ++b)
#pragma unroll
            for (int m = 0; m < 4; ++m)
#pragma unroll
                for (int n = 0; n < 2; ++n) acc[a][b][m][n] = (f32x4){0.f, 0.f, 0.f, 0.f};
    bf16x8 At[4][2], B0[2][2], B1[2][2];
    const char* cA = PG8_UA(cur); const char* cB = PG8_UB(cur);
    S.a_ready(cur);
    if constexpr (SP2) {
        PG8_STAGE(PG8_SB(0, 0), cB, voffB); PG8_STAGE(PG8_SB(0, 1), cB + hsB, voffB); PG8_STAGE(PG8_SA(0, 0), cA, voffA); PG8_STAGE(PG8_SA(0, 1), cA + hsA, voffA);
        if (wr == 1) PG8_BAR;
        PG8_WAIT_V(2); PG8_BAR;
        PG8_STAGE(PG8_SB(1, 0), cB + kstep, voffB); PG8_STAGE(PG8_SA(1, 0), cA + kstep, voffA); PG8_STAGE(PG8_SB(1, 1), cB + hsB + kstep, voffB);
        PG8_WAIT_V(6); PG8_BAR;
    } else {
        PG8_STAGE(PG8_SB(0, 0), cB, voffB); PG8_STAGE(PG8_SA(0, 0), cA, voffA); PG8_STAGE(PG8_SB(0, 1), cB + hsB, voffB); PG8_STAGE(PG8_SA(0, 1), cA + hsA, voffA);
        if (wr == 1) PG8_BAR;
        PG8_WAIT_V(4); PG8_BAR;
        PG8_STAGE(PG8_SB(1, 0), cB + kstep, voffB); PG8_STAGE(PG8_SA(1, 0), cA + kstep, voffA); PG8_STAGE(PG8_SB(1, 1), cB + hsB + kstep, voffB);
        PG8_WAIT_V(6); PG8_BAR;
    }
    for (;;) {
        const bool has_next = S.next(ui + 1, nxt);
        const char* nA = has_next ? PG8_UA(nxt) : cA; const char* nB = has_next ? PG8_UB(nxt) : cB;
        for (int t = 0; t < nt; t += 2) {
            const bool last = (t == nt - 2);
            const char* a1 = cA + (size_t)(t + 1) * kstep;
            const char* a2 = last ? nA : cA + (size_t)(t + 2) * kstep; const char* b2 = last ? nB : cB + (size_t)(t + 2) * kstep;
            const char* a3 = a2 + kstep; const char* b3 = b2 + kstep;
            if (last && has_next) S.a_ready(nxt);
            if constexpr (SP2) {
            PG8_LDB(B0, 0, 0); PG8_LDB(B1, 0, 1); PG8_SCHED; PG8_LDA(At, 0, 0); PG8_STAGE(PG8_SA(1, 1), a1 + hsA, voffA);
            PG8_WAIT_V(8); PG8_WAIT_L(0); PG8_BAR; PG8_MMA(0, 0, At, B0); PG8_MMA(0, 1, At, B1); PG8_BAR; PG8_SCHED;
            PG8_LDA(At, 0, 1); PG8_STAGE(PG8_SB(0, 0), b2, voffB); PG8_STAGE(PG8_SB(0, 1), b2 + hsB, voffB); PG8_STAGE(PG8_SA(0, 0), a2, voffA);
            PG8_WAIT_V(8); PG8_WAIT_L(0); PG8_BAR; PG8_MMA(1, 0, At, B0); PG8_MMA(1, 1, At, B1); PG8_BAR; PG8_SCHED;
            PG8_LDB(B0, 1, 0); PG8_LDB(B1, 1, 1); PG8_SCHED; PG8_LDA(At, 1, 0); PG8_STAGE(PG8_SA(0, 1), a2 + hsA, voffA);
            PG8_WAIT_V(8); PG8_WAIT_L(0); PG8_BAR; PG8_MMA(0, 0, At, B0); PG8_MMA(0, 1, At, B1); PG8_BAR; PG8_SCHED;
            PG8_LDA(At, 1, 1); PG8_STAGE(PG8_SB(1, 0), b3, voffB); PG8_STAGE(PG8_SB(1, 1), b3 + hsB, voffB); PG8_STAGE(PG8_SA(1, 0), a3, voffA);
            PG8_WAIT_V(8); PG8_WAIT_L(0); PG8_BAR; PG8_MMA(1, 0, At, B0); PG8_MMA(1, 1, At, B1); PG8_BAR; PG8_SCHED;
            } else {
            PG8_LDB(B0, 0, 0); PG8_SCHED; PG8_LDA(At, 0, 0); PG8_STAGE(PG8_SA(1, 1), a1 + hsA, voffA);
            PG8_WAIT_L(8); PG8_BAR; PG8_WAIT_L(0); PG8_MMA(0, 0, At, B0); PG8_BAR; PG8_SCHED;
            PG8_LDB(B1, 0, 1); PG8_STAGE(PG8_SB(0, 0), b2, voffB);
            PG8_BAR; PG8_WAIT_L(0); PG8_MMA(0, 1, At, B1); PG8_BAR;
            PG8_LDA(At, 0, 1); PG8_STAGE(PG8_SA(0, 0), a2, voffA);
            PG8_BAR; PG8_WAIT_L(0); PG8_MMA(1, 0, At, B0); PG8_BAR; PG8_SCHED;
            PG8_STAGE(PG8_SB(0, 1), b2 + hsB, voffB);
            PG8_WAIT_V(6); PG8_BAR; PG8_MMA(1, 1, At, B1); PG8_BAR;
            PG8_LDB(B0, 1, 0); PG8_SCHED; PG8_LDA(At, 1, 0); PG8_STAGE(PG8_SA(0, 1), a2 + hsA, voffA);
            PG8_WAIT_L(8); PG8_BAR; PG8_WAIT_L(0); PG8_MMA(0, 0, At, B0); PG8_BAR; PG8_SCHED;
            PG8_LDB(B1, 1, 1); PG8_STAGE(PG8_SB(1, 0), b3, voffB);
            PG8_BAR; PG8_WAIT_L(0); PG8_MMA(0, 1, At, B1); PG8_BAR;
            PG8_LDA(At, 1, 1); PG8_STAGE(PG8_SA(1, 0), a3, voffA);
            PG8_BAR; PG8_WAIT_L(0); PG8_MMA(1, 0, At, B0); PG8_BAR; PG8_SCHED;
            PG8_STAGE(PG8_SB(1, 1), b3 + hsB, voffB);
            PG8_WAIT_V(6); PG8_BAR; PG8_MMA(1, 1, At, B1); PG8_BAR;
            }
        }
        if constexpr (ALIGN_EPI) { if (wr == 0) PG8_BAR; }
        if constexpr (!Epi::AFTER_DRAIN) { E(acc, cur, wr, wc, fr, fq); S.done(cur); }
        if (!has_next) break;
#pragma unroll
        for (int a = 0; a < 2; ++a)
#pragma unroll
            for (int b = 0; b < 2; ++b)
#pragma unroll
                for (int m = 0; m < 4; ++m)
#pragma unroll
                    for (int n = 0; n < 2; ++n) acc[a][b][m][n] = (f32x4){0.f, 0.f, 0.f, 0.f};
        cur = nxt; cA = nA; cB = nB; ++ui;
        if constexpr (ALIGN_EPI) { if (wr == 1) PG8_BAR; }
    }
    PG8_WAIT_V(0);
    if constexpr (!ALIGN_EPI) { if (wr == 0) PG8_BAR; }
    PG8_BAR;
    if constexpr (Epi::AFTER_DRAIN) { E.fused(acc, cur, wr, wc, fr, fq, lds, wid, lane); S.done(cur); }
#undef PG8_UA
#undef PG8_UB
#undef PG8_SA
#undef PG8_SB
#undef PG8_STAGE
#undef PG8_LDA
#undef PG8_LDB
#undef PG8_MMA
#undef PG8_WAIT_V
#undef PG8_WAIT_L
#undef PG8_BAR
#undef PG8_SCHED
}
}

typedef unsigned short bf16;
typedef short bf16x8 __attribute__((ext_vector_type(8)));
typedef float f32x4 __attribute__((ext_vector_type(4)));
typedef unsigned v4u __attribute__((ext_vector_type(4)));
typedef unsigned v2u __attribute__((ext_vector_type(2)));
typedef float f32x2_t __attribute__((ext_vector_type(2)));
#define LAS __attribute__((address_space(3)))
#define DI __device__ __forceinline__
constexpr int D = 2048, BATCH = 4, SEQ = 4096, DEPTH = 4, NH = 16, HD = 128, DFF = 5632;
constexpr int M = BATCH * SEQ;
constexpr int NPROJ = 14336;
constexpr int NPO = 12288;
constexpr int NIN = 14368;
constexpr int C_Q = 0, C_K = 2048, C_V = 4096, C_ZG = 6144, C_P = 8192, C_GB = 10240;
constexpr float EPS = 1e-6f;
constexpr int NWAVES = 8, NTHREADS = 512;

constexpr size_t MiB = 1u << 20;
constexpr size_t WS_CTL = 0;
constexpr size_t WS_WIN = 1 * MiB;
constexpr size_t WS_WOUT = 226 * MiB;
constexpr size_t WS_WUP = 258 * MiB;
constexpr size_t WS_WDN = 434 * MiB;
constexpr size_t WS_WPL = 522 * MiB;
constexpr size_t WS_H = 530 * MiB;
constexpr size_t WS_BA = 594 * MiB;
constexpr size_t WS_BETA = 596 * MiB;
constexpr size_t WS_G = 597 * MiB;
constexpr size_t WS_PROJ = 598 * MiB;
constexpr size_t WS_BIG2 = 1046 * MiB;
constexpr size_t WS_O = 1430 * MiB;
constexpr size_t WS_POOLED = WS_H;
constexpr size_t WS_YB = 1622 * MiB;
constexpr size_t WS_MIXED = WS_H;
constexpr size_t WS_EDGE = 1750 * MiB;
constexpr size_t WS_END = 1760 * MiB;
static_assert(WS_WIN + (size_t)4 * NIN * D * 2 <= WS_WOUT && WS_WUP + (size_t)4 * 2 * DFF * D * 2 <= WS_WDN && WS_WDN + (size_t)4 * D * DFF * 2 <= WS_WPL, "ws map");
static_assert(WS_PROJ + (size_t)M * NPROJ * 2 <= WS_BIG2 && WS_BIG2 + (size_t)3 * M * D * 4 <= WS_O, "ws map");

struct Ctx { const float* in[16]; float* out; unsigned char* ws; };
typedef LAS const unsigned long long* PTab;
DI unsigned long long tab_ld(PTab T, int i) { const unsigned long long v = T[i]; const unsigned lo = __builtin_amdgcn_readfirstlane((unsigned)v), hi = __builtin_amdgcn_readfirstlane((unsigned)(v >> 32)); return ((unsigned long long)hi << 32) | lo; }
#define GAS __attribute__((address_space(1)))
DI const float* inp(PTab T, int i) { return (const float*)(const GAS float*)tab_ld(T, i); }
DI float* outp(PTab T) { return (float*)(GAS float*)tab_ld(T, 16); }
DI unsigned char* wsp(PTab T) { return (unsigned char*)(GAS unsigned char*)tab_ld(T, 17); }
enum { I_X = 0, I_NMW, I_WIN, I_CQW, I_ALOG, I_DTB, I_GNW, I_PW, I_PS, I_WOUT, I_NFW, I_WUP, I_CFW, I_CFB, I_WDN, I_NFIN };

DI int otid() { int t = threadIdx.x; asm volatile("" : "+v"(t)); return t; }
DI float bf2f(bf16 b) { return __uint_as_float(((unsigned)b) << 16); }
DI unsigned f2bf(float f) { unsigned u = __float_as_uint(f); return (u + 0x7fffu + ((u >> 16) & 1u)) >> 16; }
DI unsigned pk2(float lo, float hi) { return f2bf(lo) | (f2bf(hi) << 16); }
DI float lo16(unsigned w) { return __uint_as_float(w << 16); }
DI float hi16(unsigned w) { return __uint_as_float(w & 0xffff0000u); }
DI float wave_sum(float v) {
#pragma unroll
    for (int o = 1; o < 64; o <<= 1) v += __shfl_xor(v, o);
    return v;
}
DI float sigmoidf_(float x) { return 1.0f / (1.0f + expf(-x)); }
DI float siluf_(float x) { return x / (1.0f + expf(-x)); }
DI float softplusf_(float x) { return fmaxf(x, 0.f) + log1pf(expf(-fabsf(x))); }
DI float fexp(float x) { return __builtin_amdgcn_exp2f(x * 1.4426950408889634f); }
DI float frcp(float x) { return __builtin_amdgcn_rcpf(x); }
DI float frsq(float x) { return __builtin_amdgcn_rsqf(x); }
DI float fsigmoid(float x) { return frcp(1.0f + fexp(-x)); }
DI float fsilu(float x) { return x * frcp(1.0f + fexp(-x)); }
DI float gelu_erf(float x) { return 0.5f * x * (1.0f + erff(x * 0.70710678118654752f)); }

constexpr int IT_IN = (D / 64) * (NIN / 32), IT_OUT = (D / 64) * (D / 32), IT_UP = (D / 64) * (2 * DFF / 32), IT_DN = (DFF / 64) * (D / 32), IT_PL = 4 * (512 / 64) * (512 / 32);
constexpr int IT_LAYER = IT_IN + IT_OUT + IT_UP + IT_DN + IT_PL;
struct CvItem { const float* src; bf16* dst; int ldw, K; };
DI CvItem cv_decode(PTab T, int it, int lane) {
    unsigned char* const ws = wsp(T);
    const int l = it / IT_LAYER; int r = it % IT_LAYER; CvItem c;
    const float* W; int ldw, sc, k0, K, n0; bf16* WT;
    if (r < IT_IN) { const int nblk = NIN / 32, kb = r / nblk, nb = r % nblk; n0 = 32 * nb; { const int pn = n0 >> 8, bj = (n0 >> 7) & 1, jj = n0 & 127;
            sc = pn < 24 ? n0 : pn < 40 ? (bj ? 10272 : 6144) + 128 * (pn - 24) + jj : pn < 48 ? 8224 + (n0 - 40 * 256) : pn < 56 ? 12320 + (n0 - 48 * 256) : 8192 + (n0 - NPROJ); }
        W = inp(T, I_WIN) + (size_t)l * D * NIN; ldw = NIN; k0 = 64 * kb; WT = (bf16*)(ws + WS_WIN) + (size_t)(l & 1) * NIN * D; K = D; }
    else if ((r -= IT_IN) < IT_PL) { const int g = r / 128, rr = r % 128, kb = rr / 16, nb = rr % 16; sc = 32 * nb; n0 = g * 512 + 32 * nb;
        W = inp(T, I_PW) + (size_t)(l * 4 + g) * 512 * 512; ldw = 512; k0 = 64 * kb; WT = (bf16*)(ws + WS_WPL) + (size_t)(l & 1) * D * 512; K = 512; }
    else if ((r -= IT_PL) < IT_OUT) { const int nblk = D / 32, kb = r / nblk, nb = r % nblk; n0 = 32 * nb; sc = n0; W = inp(T, I_WOUT) + (size_t)l * D * D; ldw = D; k0 = 64 * kb; WT = (bf16*)(ws + WS_WOUT) + (size_t)(l & 1) * D * D; K = D; }
    else if ((r -= IT_OUT) < IT_UP) { const int nblk = 2 * DFF / 32, kb = r / nblk, nb = r % nblk; n0 = 32 * nb; sc = ((n0 >> 7) & 1) * DFF + 128 * (n0 >> 8) + (n0 & 127);
        W = inp(T, I_WUP) + (size_t)l * D * 2 * DFF; ldw = 2 * DFF; k0 = 64 * kb; WT = (bf16*)(ws + WS_WUP) + (size_t)(l & 1) * 2 * DFF * D; K = D; }
    else { r -= IT_UP; const int nblk = D / 32, kb = r / nblk, nb = r % nblk; n0 = 32 * nb; sc = n0; W = inp(T, I_WDN) + (size_t)l * DFF * D; ldw = D; k0 = 64 * kb; WT = (bf16*)(ws + WS_WDN) + (size_t)(l & 1) * D * DFF; K = DFF; }
    c.src = W + (size_t)(k0 + (lane >> 3)) * ldw + sc + 4 * (lane & 7); c.dst = WT + (size_t)n0 * K + k0; c.ldw = ldw; c.K = K; return c;
}
DI void cv_load(const CvItem& c, float (&v)[32]) {
#pragma unroll
    for (int i = 0; i < 8; ++i) { const f32x4 t = *(const f32x4*)(c.src + (size_t)(8 * i) * c.ldw); v[4 * i] = t.x; v[4 * i + 1] = t.y; v[4 * i + 2] = t.z; v[4 * i + 3] = t.w; }
}
DI void cv_store(const CvItem& c, const float (&v)[32], LAS float* scr, int lane) {
#pragma unroll
    for (int i = 0; i < 8; ++i)
#pragma unroll
        for (int e = 0; e < 4; ++e) scr[(8 * i + (lane >> 3)) * 33 + 4 * (lane & 7) + e] = v[4 * i + e];
    asm volatile("s_waitcnt lgkmcnt(0)" ::: "memory");
    const int cc = lane & 7;
#pragma unroll
    for (int j = 0; j < 4; ++j) { const int n = (lane >> 3) + 8 * j; const LAS float* s = scr + (8 * cc) * 33 + n;
        v4u o; o.x = pk2(s[0 * 33], s[1 * 33]); o.y = pk2(s[2 * 33], s[3 * 33]); o.z = pk2(s[4 * 33], s[5 * 33]); o.w = pk2(s[6 * 33], s[7 * 33]);
        *(v4u*)(c.dst + (size_t)n * c.K + 8 * cc) = o; }
    asm volatile("s_waitcnt lgkmcnt(0)" ::: "memory");
}
constexpr int IT_FIRST = IT_IN + IT_PL;
DI void ph_convert(PTab T, LAS unsigned char* lds, int base, int end, int wg0) {
    const int tid = otid(), lane = tid & 63, wave = __builtin_amdgcn_readfirstlane(tid >> 6), gw = ((int)blockIdx.x - wg0) * NWAVES + wave, ngw = ((int)gridDim.x - wg0) * NWAVES;
    LAS float* scr = (LAS float*)(lds + wave * 16384);
    float va[32], vb[32];
    int it = base + gw; if (gw < 0 || it >= end) return;
    CvItem ca = cv_decode(T, it, lane); cv_load(ca, va);
    for (;;) {
        const int itb = it + ngw; const bool hb = itb < end; CvItem cb = ca;
        if (hb) { cb = cv_decode(T, itb, lane); cv_load(cb, vb); }
        cv_store(ca, va, scr, lane);
        if (!hb) break;
        const int itc = itb + ngw; const bool hc = itc < end;
        if (hc) { ca = cv_decode(T, itc, lane); cv_load(ca, va); }
        cv_store(cb, vb, scr, lane);
        if (!hc) break;
        it = itc;
    }
}

DI void ph_rmsnorm_bf16(const float* x, const float* w, bf16* out) {
    const int tid = otid(), lane = tid & 63, wave = __builtin_amdgcn_readfirstlane(tid >> 6), gw = blockIdx.x * NWAVES + wave, ngw = gridDim.x * NWAVES;
    for (int m = gw; m < M; m += ngw) {
        const f32x4* xr = (const f32x4*)(x + (size_t)m * D) + 2 * lane; f32x4 v[8]; float s = 0.f;
#pragma unroll
        for (int j = 0; j < 8; ++j) { v[j] = xr[128 * (j >> 1) + (j & 1)]; s += (v[j].x * v[j].x + v[j].y * v[j].y) + (v[j].z * v[j].z + v[j].w * v[j].w); }
        const float rstd = 1.0f / sqrtf(wave_sum(s) * (1.0f / D) + EPS);
        v4u* o = (v4u*)(out + (size_t)m * D) + lane;
#pragma unroll
        for (int jj = 0; jj < 4; ++jj) { const f32x4 w0 = ((const f32x4*)w)[2 * lane + 128 * jj], w1 = ((const f32x4*)w)[2 * lane + 128 * jj + 1]; const f32x4 a = v[2 * jj], b = v[2 * jj + 1]; v4u p;
            p.x = pk2(a.x * rstd * w0.x, a.y * rstd * w0.y); p.y = pk2(a.z * rstd * w0.z, a.w * rstd * w0.w); p.z = pk2(b.x * rstd * w1.x, b.y * rstd * w1.y); p.w = pk2(b.z * rstd * w1.z, b.w * rstd * w1.w); o[64 * jj] = p; }
    }
}
DI void ph_rmsnorm_f32(const float* x, const float* w, float* out) {
    const int tid = otid(), lane = tid & 63, wave = __builtin_amdgcn_readfirstlane(tid >> 6), gw = blockIdx.x * NWAVES + wave, ngw = gridDim.x * NWAVES;
    for (int m = gw; m < M; m += ngw) {
        const f32x4* xr = (const f32x4*)(x + (size_t)m * D) + lane; f32x4 v[8]; float s = 0.f;
#pragma unroll
        for (int j = 0; j < 8; ++j) { v[j] = xr[64 * j]; s += (v[j].x * v[j].x + v[j].y * v[j].y) + (v[j].z * v[j].z + v[j].w * v[j].w); }
        const float rstd = 1.0f / sqrtf(wave_sum(s) * (1.0f / D) + EPS);
        f32x4* o = (f32x4*)(out + (size_t)m * D) + lane;
#pragma unroll
        for (int j = 0; j < 8; ++j) { const f32x4 ww = ((const f32x4*)w)[lane + 64 * j]; o[64 * j] = (f32x4){v[j].x * rstd * ww.x, v[j].y * rstd * ww.y, v[j].z * rstd * ww.z, v[j].w * rstd * ww.w}; }
    }
}

DI void ph_ba(PTab T, int l, LAS unsigned char* lds) {
    const int tid = otid(), lane = tid & 63, wave = __builtin_amdgcn_readfirstlane(tid >> 6);
    unsigned char* const ws = wsp(T);
    const bf16* H = (const bf16*)(ws + WS_H); const bf16* Wt = (const bf16*)(ws + WS_WIN) + ((size_t)(l & 1) * NIN + NPROJ) * D; float* BA = (float*)(ws + WS_BA);
    const int r = lane & 15, g = lane >> 4, w4 = wave & 3, kh = wave >> 2;
    LAS f32x4* xch = (LAS f32x4*)lds + (w4 * 64 + lane) * 2;
    for (int wt = blockIdx.x * 4 + w4; wt < M / 16; wt += gridDim.x * 4) {
        const bf16* ap = H + (size_t)(wt * 16 + r) * D + 8 * g + kh * (D / 2); const bf16* b0p = Wt + (size_t)r * D + 8 * g + kh * (D / 2); const bf16* b1p = Wt + (size_t)(16 + r) * D + 8 * g + kh * (D / 2);
        f32x4 acc0 = {0.f, 0.f, 0.f, 0.f}, acc1 = {0.f, 0.f, 0.f, 0.f};
        bf16x8 xa[8], xb[8], xc[8], ya[8], yb[8], yc[8];
#define BA_LD(A_, B_, C_, k1) do { _Pragma("unroll") for (int i = 0; i < 8; ++i) { A_[i] = *(const bf16x8*)(ap + (k1) + 32 * i); B_[i] = *(const bf16x8*)(b0p + (k1) + 32 * i); C_[i] = *(const bf16x8*)(b1p + (k1) + 32 * i); } } while (0)
#define BA_MM(A_, B_, C_) do { _Pragma("unroll") for (int i = 0; i < 8; ++i) { acc0 = __builtin_amdgcn_mfma_f32_16x16x32_bf16(A_[i], B_[i], acc0, 0, 0, 0); acc1 = __builtin_amdgcn_mfma_f32_16x16x32_bf16(A_[i], C_[i], acc1, 0, 0, 0); } } while (0)
        BA_LD(xa, xb, xc, 0); BA_LD(ya, yb, yc, 256);
        BA_MM(xa, xb, xc); __builtin_amdgcn_sched_barrier(0); BA_LD(xa, xb, xc, 512); __builtin_amdgcn_sched_barrier(0);
        BA_MM(ya, yb, yc); __builtin_amdgcn_sched_barrier(0); BA_LD(ya, yb, yc, 768); __builtin_amdgcn_sched_barrier(0);
        BA_MM(xa, xb, xc); BA_MM(ya, yb, yc);
#undef BA_LD
#undef BA_MM
        if (kh) { xch[0] = acc0; xch[1] = acc1; }
        __syncthreads();
        if (!kh) { acc0 += xch[0]; acc1 += xch[1];
#pragma unroll
            for (int j = 0; j < 4; ++j) { float* o = BA + (size_t)(wt * 16 + 4 * g + j) * 32; o[r] = acc0[j]; o[16 + r] = acc1[j]; } }
        __syncthreads();
    }
}

template <int WIN> DI void pooled_run(const bf16* P, bf16* PO, int m0, int col) {
    constexpr int B = 8;
    float s[8]; const int t0 = m0 & (SEQ - 1);
#pragma unroll
    for (int e = 0; e < 8; ++e) s[e] = 0.f;
    { v4u w[WIN];
#pragma unroll
      for (int j = 0; j < WIN; ++j) w[j] = (t0 - WIN + j >= 0) ? *(const v4u*)(P + (size_t)(m0 - WIN + j) * NPO + col) : (v4u){0u, 0u, 0u, 0u};
#pragma unroll
      for (int j = 0; j < WIN; ++j)
#pragma unroll
          for (int e = 0; e < 4; ++e) { s[2 * e] += lo16(w[j][e]); s[2 * e + 1] += hi16(w[j][e]); } }
    for (int base = 0; base < 32; base += B) {
        v4u xn[B], xo[B];
#pragma unroll
        for (int j = 0; j < B; ++j) xn[j] = *(const v4u*)(P + (size_t)(m0 + base + j) * NPO + col);
#pragma unroll
        for (int j = 0; j < B; ++j) xo[j] = (t0 + base + j - WIN >= 0) ? *(const v4u*)(P + (size_t)(m0 + base + j - WIN) * NPO + col) : (v4u){0u, 0u, 0u, 0u};
#pragma unroll
        for (int j = 0; j < B; ++j) { const int t = t0 + base + j; const float inv = frcp((float)((t + 1) < WIN ? (t + 1) : WIN)); v4u o;
#pragma unroll
            for (int e = 0; e < 4; ++e) { const float x0 = lo16(xn[j][e]), x1 = hi16(xn[j][e]); s[2 * e] += x0 - lo16(xo[j][e]); s[2 * e + 1] += x1 - hi16(xo[j][e]); o[e] = pk2(s[2 * e] * inv - x0, s[2 * e + 1] * inv - x1); }
            *(v4u*)(PO + (size_t)(m0 + base + j) * D + col) = o; }
    }
}
DI void ph_pooled(PTab T) {
    unsigned char* const ws = wsp(T); const bf16* P = (const bf16*)(ws + WS_PROJ) + C_P; bf16* PO = (bf16*)(ws + WS_POOLED);
    const int tid = otid();
    for (int e = blockIdx.x * NTHREADS + tid; e < (M / 32) * (D / 8); e += gridDim.x * NTHREADS) {
        const int c8 = e & 255, rb = e >> 8, col = 8 * c8, gi = c8 >> 6, m0 = rb * 32;
        if (gi == 0) pooled_run<2>(P, PO, m0, col); else if (gi == 1) pooled_run<4>(P, PO, m0, col); else if (gi == 2) pooled_run<8>(P, PO, m0, col); else pooled_run<16>(P, PO, m0, col);
    }
}
DI void ph_mix(PTab T, int l) {
    const int tid = otid(); unsigned char* const ws = wsp(T);
    const bf16* P = (const bf16*)(ws + WS_PROJ); const bf16* Y = (const bf16*)(ws + WS_O); const float* SSO = (const float*)(ws + WS_G); const bf16* YB = (const bf16*)(ws + WS_YB); bf16* MX = (bf16*)(ws + WS_MIXED);
    const float* gnw = inp(T, I_GNW) + l * HD;
    for (int e = blockIdx.x * NTHREADS + tid; e < M * (D / 8); e += gridDim.x * NTHREADS) {
        const int m = e >> 8, cb = e & 255, col = 8 * cb, hh = cb >> 4;
        const v4u o = *(const v4u*)(Y + (size_t)m * D + col), zg = *(const v4u*)(P + (size_t)m * NPO + C_ZG + col), yb = *(const v4u*)(YB + (size_t)m * D + col);
        const float rstd = frsq(SSO[(size_t)m * 16 + hh] * (1.0f / HD) + EPS);
        const f32x4 g0 = *(const f32x4*)(gnw + (col & 127)) * rstd, g1 = *(const f32x4*)(gnw + (col & 127) + 4) * rstd;
        v4u r;
#pragma unroll
        for (int i = 0; i < 4; ++i) { const float gl = (i < 2) ? g0[2 * i] : g1[2 * i - 4], gh = (i < 2) ? g0[2 * i + 1] : g1[2 * i - 3];
            r[i] = pk2(lo16(zg[i]) * (lo16(o[i]) * gl) + lo16(yb[i]), hi16(zg[i]) * (hi16(o[i]) * gh) + hi16(yb[i])); }
        *(v4u*)(MX + (size_t)m * D + col) = r;
    }
}
DI void ph_glu_fix(PTab T, int l) {
    unsigned char* const ws = wsp(T); const float* edge = (const float*)(ws + WS_EDGE); bf16* ACT = (bf16*)(ws + WS_BIG2);
    const float* cw = inp(T, I_CFW) + (size_t)l * 3 * DFF; const float* cb = inp(T, I_CFB) + (size_t)l * DFF;
    const int tid = otid();
    for (int e = blockIdx.x * NTHREADS + tid; e < 64 * DFF; e += gridDim.x * NTHREADS) {
        const int pm = e / DFF, f = e % DFF; if ((pm & 15) == 0) continue;
        const float gm2 = edge[((size_t)((0 * 64 + pm - 1) * 2 + 0)) * DFF + f], gm1 = edge[((size_t)((0 * 64 + pm - 1) * 2 + 1)) * DFF + f];
        const float g0 = edge[((size_t)((1 * 64 + pm) * 2 + 0)) * DFF + f], g1 = edge[((size_t)((1 * 64 + pm) * 2 + 1)) * DFF + f];
        const float u0 = edge[((size_t)((2 * 64 + pm) * 2 + 0)) * DFF + f], u1 = edge[((size_t)((2 * 64 + pm) * 2 + 1)) * DFF + f];
        const float w0 = cw[f], w1 = cw[DFF + f], w2 = cw[2 * DFF + f], bb = cb[f];
        ACT[(size_t)(pm * 256) * DFF + f] = (bf16)f2bf(gelu_erf(w0 * gm2 + w1 * gm1 + w2 * g0 + bb) * u0);
        ACT[(size_t)(pm * 256 + 1) * DFF + f] = (bf16)f2bf(gelu_erf(w0 * gm1 + w1 * g0 + w2 * g1 + bb) * u1);
    }
}
typedef float f32x16 __attribute__((ext_vector_type(16)));
typedef __bf16 bf16x2_t __attribute__((ext_vector_type(2)));
DI unsigned cvtpk(float lo, float hi) { const f32x2_t v = {lo, hi}; const bf16x2_t b = __builtin_convertvector(v, bf16x2_t); return __builtin_bit_cast(unsigned, b); }
DI bf16x8 mk8(float a0, float a1, float a2, float a3, float a4, float a5, float a6, float a7) { v4u p; p.x = cvtpk(a0, a1); p.y = cvtpk(a2, a3); p.z = cvtpk(a4, a5); p.w = cvtpk(a6, a7); return __builtin_bit_cast(bf16x8, p); }
#define MFMA32(a, b, c) __builtin_amdgcn_mfma_f32_32x32x16_bf16((a), (b), (c), 0, 0, 0)
#define PACK_STEP(x, s) mk8((x)[8 * (s)], (x)[8 * (s) + 1], (x)[8 * (s) + 2], (x)[8 * (s) + 3], (x)[8 * (s) + 4], (x)[8 * (s) + 5], (x)[8 * (s) + 6], (x)[8 * (s) + 7])
DI f32x16 zero16() { f32x16 z; for (int i = 0; i < 16; ++i) z[i] = 0.f; return z; }
DI bf16x8 frag_row(const LAS float* p) { const f32x4 a = *(const LAS f32x4*)p, b = *(const LAS f32x4*)(p + 4); return mk8(a.x, a.y, a.z, a.w, b.x, b.y, b.z, b.w); }
DI bf16x8 frag_row_s(const LAS float* p, const LAS float* f) { const f32x4 a = *(const LAS f32x4*)p, b = *(const LAS f32x4*)(p + 4), fa = *(const LAS f32x4*)f, fb = *(const LAS f32x4*)(f + 4);
    return mk8(a.x * fa.x, a.y * fa.y, a.z * fa.z, a.w * fa.w, b.x * fb.x, b.y * fb.y, b.z * fb.z, b.w * fb.w); }
DI bf16x8 frag_col(const LAS float* p, int stride) { return mk8(p[0], p[stride], p[2 * stride], p[3 * stride], p[4 * stride], p[5 * stride], p[6 * stride], p[7 * stride]); }

constexpr int OFF_WT = 0, OFF_QDT = 16384, OFF_KE = 32768, OFF_ATT = 49152, OFF_U = 55296, MAIN_BYTES = 49152, ATT_BYTES = 6144, UNIT_BYTES = 71680;
constexpr int NUNITS = BATCH * NH * (SEQ / 64);
static_assert((size_t)NUNITS * UNIT_BYTES <= 384 * MiB, "gdn image fits its region");
constexpr int QS = 132, LS = 68;
constexpr int L_QN = 0, L_KN = 64 * QS * 4, L_VN = 2 * 64 * QS * 4, L_LM = 3 * 64 * QS * 4, L_TM = L_LM + 64 * LS * 4, L_VEC = L_TM + 64 * LS * 4;
static_assert(L_VEC + 5 * 256 <= 161792, "chunk-local LDS map");

#define LDS_BAR() do { asm volatile("s_waitcnt lgkmcnt(0)" ::: "memory"); __builtin_amdgcn_s_barrier(); asm volatile("" ::: "memory"); } while (0)
struct ChunkIn { v4u raw[3][5]; float b_raw, a_raw; };
DI void gdn_chunk_load(PTab T, int unit, ChunkIn& in, int lane, int w) {
    unsigned char* const ws = wsp(T);
    const int bh = unit >> 6, n = unit & 63, b = bh >> 4, hh = bh & 15, m0 = b * SEQ + n * 64, q4 = lane >> 4;
    const bf16* P = (const bf16*)(ws + WS_PROJ) + (size_t)hh * HD + 8 * (lane & 15);
#pragma unroll
    for (int sec = 0; sec < 3; ++sec)
#pragma unroll
        for (int i = 0; i < 5; ++i) { const int rr = 8 * w + 2 * q4 - 3 + i; in.raw[sec][i] = (n * 64 + rr >= 0) ? *(const v4u*)(P + (size_t)(m0 + rr) * NPO + sec * D) : (v4u){0u, 0u, 0u, 0u}; }
    if (w == 0) { const float* ba = (const float*)(ws + WS_BA) + (size_t)(m0 + lane) * 32; in.b_raw = ba[hh]; in.a_raw = ba[16 + hh]; } else { in.b_raw = 0.f; in.a_raw = 0.f; }
}
DI void gdn_chunk_unit(PTab T, int l, LAS unsigned char* lds, int unit, int next_unit, ChunkIn& in) {
    const int tid = otid(), lane = tid & 63, w = __builtin_amdgcn_readfirstlane(tid >> 6), c = lane & 31, h = lane >> 5;
    unsigned char* const ws = wsp(T);
    const int bh = unit >> 6, hh = bh & 15;
    LAS float* QN = (LAS float*)(lds + L_QN); LAS float* KN = (LAS float*)(lds + L_KN); LAS float* VN = (LAS float*)(lds + L_VN);
    LAS float* LM = (LAS float*)(lds + L_LM); LAS float* TM = (LAS float*)(lds + L_TM);
    LAS float* VG = (LAS float*)(lds + L_VEC); LAS float* VBETA = VG + 64; LAS float* VEG = VG + 128; LAS float* VEKE = VG + 192; LAS float* VBEG = VG + 256;
    unsigned char* const ub = ws + WS_BIG2 + (size_t)unit * UNIT_BYTES;
    {
        const int q4 = lane >> 4, c8 = 8 * (lane & 15);
        const float* cw = inp(T, I_CQW) + (size_t)l * 4 * 3 * D + hh * HD + c8;
#pragma unroll
        for (int sec = 0; sec < 3; ++sec) {
            f32x4 wa[4], wb[4];
#pragma unroll
            for (int j = 0; j < 4; ++j) { wa[j] = *(const f32x4*)(cw + (size_t)j * 3 * D + sec * D); wb[j] = *(const f32x4*)(cw + (size_t)j * 3 * D + sec * D + 4); }
            LAS float* dst = (sec == 0 ? QN : sec == 1 ? KN : VN) + c8;
            float a[2][8];
#pragma unroll
            for (int r = 0; r < 2; ++r) { float x[8];
#pragma unroll
                for (int e = 0; e < 8; ++e) x[e] = 0.f;
#pragma unroll
                for (int j = 0; j < 4; ++j) { const v4u rw = in.raw[sec][r + j];
#pragma unroll
                    for (int e = 0; e < 4; ++e) { const float wl = (e < 2) ? wa[j][2 * e] : wb[j][2 * e - 4], wh = (e < 2) ? wa[j][2 * e + 1] : wb[j][2 * e - 3]; x[2 * e] += wl * lo16(rw[e]); x[2 * e + 1] += wh * hi16(rw[e]); } }
#pragma unroll
                for (int e = 0; e < 8; ++e) a[r][e] = fsilu(x[e]); }
            if (sec < 2) {
                float ss[2];
#pragma unroll
                for (int r = 0; r < 2; ++r) { ss[r] = 0.f;
#pragma unroll
                    for (int e = 0; e < 8; ++e) ss[r] += a[r][e] * a[r][e]; }
#pragma unroll
                for (int o = 1; o < 16; o <<= 1)
#pragma unroll
                    for (int r = 0; r < 2; ++r) ss[r] += __shfl_xor(ss[r], o);
#pragma unroll
                for (int r = 0; r < 2; ++r) { float sc = frsq(ss[r] + EPS); if (sec == 0) sc *= 0.08838834764831845f;
#pragma unroll
                    for (int e = 0; e < 8; ++e) a[r][e] *= sc; }
            }
#pragma unroll
            for (int r = 0; r < 2; ++r) { LAS float* d = dst + (8 * w + 2 * q4 + r) * QS; *(LAS f32x4*)d = (f32x4){a[r][0], a[r][1], a[r][2], a[r][3]}; *(LAS f32x4*)(d + 4) = (f32x4){a[r][4], a[r][5], a[r][6], a[r][7]}; }
        }
        if (w == 0) {
            const float beta = fsigmoid(in.b_raw); const float sx = in.a_raw + inp(T, I_DTB)[l * NH + hh], se = fexp(-fabsf(sx));
            const float sp = fmaxf(sx, 0.f) + (se < 1e-3f ? se * (1.0f - 0.5f * se) : __builtin_amdgcn_logf(1.0f + se) * 0.6931471805599453f);
            const float g = -fexp(inp(T, I_ALOG)[l * NH + hh]) * sp;
            float G = g;
#pragma unroll
            for (int o = 1; o < 64; o <<= 1) { const float t = __shfl_up(G, o); if (lane >= o) G += t; }
            const float G63 = __shfl(G, 63); const float eg = fexp(G);
            VG[lane] = G; VBETA[lane] = beta; VEG[lane] = eg; VEKE[lane] = fexp(G63 - G); VBEG[lane] = beta * eg;
            if (lane == 63) ((float*)(ws + WS_BETA))[unit] = eg;
        }
        if (next_unit >= 0) gdn_chunk_load(T, next_unit, in, lane, w);
    }
    LDS_BAR();
    if (w < 3) {
        const int ti = (w == 0) ? 0 : 1, tj = (w == 2) ? 1 : 0;
        f32x16 acc = zero16();
#pragma unroll
        for (int ks = 0; ks < 8; ++ks) acc = MFMA32(frag_row(KN + (32 * ti + c) * QS + 16 * ks + 8 * h), frag_row(KN + (32 * tj + c) * QS + 16 * ks + 8 * h), acc);
        const int jp = 32 * tj + c; const float Gj = VG[jp];
#pragma unroll
        for (int g4 = 0; g4 < 4; ++g4) { const int ip0 = 32 * ti + 8 * g4 + 4 * h; const f32x4 Gi = *(const LAS f32x4*)(VG + ip0), Bi = *(const LAS f32x4*)(VBETA + ip0);
#pragma unroll
            for (int q = 0; q < 4; ++q) { const int ip = ip0 + q; LM[ip * LS + jp] = (ip > jp) ? Bi[q] * acc[4 * g4 + q] * fexp(Gi[q] - Gj) : 0.f; } }
    }
    LDS_BAR();
    if (w == 0) {
        { const int blk = lane >> 4, cc = lane & 15; const LAS float* Lp = LM + (16 * blk) * LS + 16 * blk; float t[16];
#pragma unroll
          for (int ii = 0; ii < 16; ++ii) {
              float a = (cc == ii) ? 1.f : 0.f;
#pragma unroll
              for (int j4 = 0; j4 < (ii + 3) / 4; ++j4) { const f32x4 lv = *(const LAS f32x4*)(Lp + ii * LS + 4 * j4);
#pragma unroll
                  for (int q = 0; q < 4; ++q) if (4 * j4 + q < ii) a -= lv[q] * t[4 * j4 + q]; }
              t[ii] = a;
          }
#pragma unroll
          for (int ii = 0; ii < 16; ++ii) TM[(16 * blk + ii) * LS + 16 * blk + cc] = t[ii];
          if (!(blk & 1)) {
#pragma unroll
              for (int ii = 0; ii < 16; ++ii) TM[(16 * blk + ii) * LS + 16 * blk + 16 + cc] = 0.f; }
        }
        asm volatile("s_waitcnt lgkmcnt(0)" ::: "memory");
        { const int p = c >> 4, r15 = c & 15, ro = p ? 48 : 16, co = p ? 32 : 0;
          const f32x16 x1 = MFMA32(frag_row(LM + (ro + r15) * LS + co + 8 * h), frag_col(TM + (co + 8 * h) * LS + co + r15, LS), zero16());
          const LAS float* tp = TM + (ro + r15) * LS + ro + 4 * h; const f32x4 a = *(const LAS f32x4*)tp, bq = *(const LAS f32x4*)(tp + 8);
          const bf16x8 xb0 = PACK_STEP(x1, 0), xb1 = PACK_STEP(x1, 1);
          const f32x16 y1 = MFMA32(mk8(a.x, a.y, a.z, a.w, bq.x, bq.y, bq.z, bq.w), p ? xb1 : xb0, zero16());
#pragma unroll
          for (int g4 = 0; g4 < 2; ++g4)
#pragma unroll
              for (int q = 0; q < 4; ++q) { const int rr = 8 * g4 + 4 * h + q; TM[(ro + rr) * LS + co + r15] = -(p ? y1[8 + 4 * g4 + q] : y1[4 * g4 + q]); }
        }
        asm volatile("s_waitcnt lgkmcnt(0)" ::: "memory");
        f32x16 x = zero16();
#pragma unroll
        for (int ks = 0; ks < 2; ++ks) x = MFMA32(frag_row(LM + (32 + c) * LS + 16 * ks + 8 * h), frag_col(TM + (16 * ks + 8 * h) * LS + c, LS), x);
        f32x16 y = zero16();
#pragma unroll
        for (int s = 0; s < 2; ++s) { const LAS float* tp = TM + (32 + c) * LS + 32 + 16 * s + 4 * h; const f32x4 a = *(const LAS f32x4*)tp, bq = *(const LAS f32x4*)(tp + 8);
            y = MFMA32(mk8(a.x, a.y, a.z, a.w, bq.x, bq.y, bq.z, bq.w), PACK_STEP(x, s), y); }
#pragma unroll
        for (int g4 = 0; g4 < 4; ++g4)
#pragma unroll
            for (int q = 0; q < 4; ++q) TM[(32 + 8 * g4 + 4 * h + q) * LS + c] = -y[4 * g4 + q];
    } else if (w < 4) {
        const int tj = (w == 3) ? 1 : 0, ti = (w == 1) ? 0 : 1, t3 = w - 1;
        f32x16 acc = zero16();
#pragma unroll
        for (int ks = 0; ks < 8; ++ks) acc = MFMA32(frag_row(KN + (32 * tj + c) * QS + 16 * ks + 8 * h), frag_row(QN + (32 * ti + c) * QS + 16 * ks + 8 * h), acc);
        const int ip = 32 * ti + c; const float Gi = VG[ip];
#pragma unroll
        for (int g4 = 0; g4 < 4; ++g4) { const int jp0 = 32 * tj + 8 * g4 + 4 * h; const f32x4 Gj = *(const LAS f32x4*)(VG + jp0);
#pragma unroll
            for (int q = 0; q < 4; ++q) acc[4 * g4 + q] = (ip >= jp0 + q) ? acc[4 * g4 + q] * fexp(Gi - Gj[q]) : 0.f; }
        *(bf16x8*)(ub + OFF_ATT + (t3 * 2 + 0) * 1024 + lane * 16) = PACK_STEP(acc, 0);
        *(bf16x8*)(ub + OFF_ATT + (t3 * 2 + 1) * 1024 + lane * 16) = PACK_STEP(acc, 1);
    } else if (w < 6) {
        const int ti = w - 4; const float e = VEG[32 * ti + c];
#pragma unroll
        for (int d = 0; d < 4; ++d)
#pragma unroll
            for (int s = 0; s < 2; ++s) { const LAS float* p = QN + (32 * ti + c) * QS + 32 * d + 16 * s + 4 * h; const f32x4 a = *(const LAS f32x4*)p, bq = *(const LAS f32x4*)(p + 8);
                *(bf16x8*)(ub + OFF_QDT + ((d * 2 + ti) * 2 + s) * 1024 + lane * 16) = mk8(a.x * e, a.y * e, a.z * e, a.w * e, bq.x * e, bq.y * e, bq.z * e, bq.w * e); }
    } else {
        const int tj = w - 6;
#pragma unroll
        for (int s = 0; s < 2; ++s) { const int tok0 = 32 * tj + 16 * s + 4 * h; const f32x4 fa = *(const LAS f32x4*)(VEKE + tok0), fb = *(const LAS f32x4*)(VEKE + tok0 + 8);
#pragma unroll
            for (int d = 0; d < 4; ++d) { const LAS float* p = KN + tok0 * QS + 32 * d + c;
                *(bf16x8*)(ub + OFF_KE + ((d * 2 + tj) * 2 + s) * 1024 + lane * 16) = mk8(p[0] * fa.x, p[QS] * fa.y, p[2 * QS] * fa.z, p[3 * QS] * fa.w, p[8 * QS] * fb.x, p[9 * QS] * fb.y, p[10 * QS] * fb.z, p[11 * QS] * fb.w); } }
    }
    LDS_BAR();
    {
        const int d = w >> 1, ti = w & 1; f32x16 acc = zero16();
#pragma unroll
        for (int ks = 0; ks < 4; ++ks) if (ks < 2 || ti == 1)
            acc = MFMA32(frag_col(KN + (16 * ks + 8 * h) * QS + 32 * d + c, QS), frag_row_s(TM + (32 * ti + c) * LS + 16 * ks + 8 * h, VBEG + 16 * ks + 8 * h), acc);
#pragma unroll
        for (int i = 0; i < 16; ++i) acc[i] = -acc[i];
        *(bf16x8*)(ub + OFF_WT + ((d * 2 + ti) * 2 + 0) * 1024 + lane * 16) = PACK_STEP(acc, 0);
        *(bf16x8*)(ub + OFF_WT + ((d * 2 + ti) * 2 + 1) * 1024 + lane * 16) = PACK_STEP(acc, 1);
    }
    {
        const int vt = w >> 1, ti = 1 - (w & 1); f32x16 acc = zero16();
#pragma unroll
        for (int ks = 0; ks < 4; ++ks) if (ks < 2 || ti == 1)
            acc = MFMA32(frag_row_s(TM + (32 * ti + c) * LS + 16 * ks + 8 * h, VBETA + 16 * ks + 8 * h), frag_col(VN + (16 * ks + 8 * h) * QS + 32 * vt + c, QS), acc);
        *(bf16x8*)(ub + OFF_U + ((ti * 4 + vt) * 2 + 0) * 1024 + lane * 16) = PACK_STEP(acc, 0);
        *(bf16x8*)(ub + OFF_U + ((ti * 4 + vt) * 2 + 1) * 1024 + lane * 16) = PACK_STEP(acc, 1);
    }
    LDS_BAR();
}
DI void ph_gdn_chunks(PTab T, int l, LAS unsigned char* lds) {
    const int per = NUNITS / gridDim.x, u0 = blockIdx.x * per, u1 = (blockIdx.x == gridDim.x - 1) ? NUNITS : u0 + per;
    const bool strided = ((int)gridDim.x * 16 == NUNITS); const int cnt = strided ? 16 : u1 - u0, ub0 = ((int)blockIdx.x >> 2) * 64 + ((int)blockIdx.x & 3);
    const int tid = otid(), lane = tid & 63, w = __builtin_amdgcn_readfirstlane(tid >> 6);
#define CH_UNIT(i) (strided ? ub0 + 4 * (15 - (i)) : u0 + (i))
    ChunkIn in; if (cnt > 0) gdn_chunk_load(T, CH_UNIT(0), in, lane, w);
    for (int i = 0; i < cnt; ++i) gdn_chunk_unit(T, l, lds, CH_UNIT(i), i + 1 < cnt ? CH_UNIT(i + 1) : -1, in);
#undef CH_UNIT
}

constexpr int A_BYTES = 49152, B_BYTES = 22528, SC_A = 0, SC_B = 2 * A_BYTES, SC_OST = SC_B + 2 * B_BYTES, OST_STRIDE = 272, SC_SSX = SC_OST + 64 * OST_STRIDE, SC_END = SC_SSX + 2048;
#define SCAN_BAR() do { asm volatile("" ::: "memory"); __builtin_amdgcn_s_barrier(); asm volatile("" ::: "memory"); } while (0)
DI f32x16 unpack16(const bf16x8 a, const bf16x8 b) {
    const v4u ua = __builtin_bit_cast(v4u, a), ub = __builtin_bit_cast(v4u, b); f32x16 r;
#pragma unroll
    for (int i = 0; i < 4; ++i) { r[2 * i] = lo16(ua[i]); r[2 * i + 1] = hi16(ua[i]); r[8 + 2 * i] = lo16(ub[i]); r[8 + 2 * i + 1] = hi16(ub[i]); }
    return r;
}
DI void ph_gdn_scan(PTab T, LAS unsigned char* lds, int bh) {
    const int tid = otid(), lane = tid & 63, w = __builtin_amdgcn_readfirstlane(tid >> 6), c = lane & 31, h = lane >> 5;
    unsigned char* const ws = wsp(T);
    const unsigned char* const gb = ws + WS_BIG2 + (size_t)bh * 64 * UNIT_BYTES;
    const int b = bh >> 4, hh = bh & 15;
    if (w >= 4) {
        const int lw = w - 4;
        float* const sso = (float*)(ws + WS_G) + (size_t)(b * SEQ + 16 * lw + (lane & 15)) * 16 + hh;
        bf16* const yrow = (bf16*)(ws + WS_O) + (size_t)(b * SEQ + 16 * lw + (lane >> 4)) * D + hh * HD + 8 * (lane & 15);
#define DMA_A(nn) do { const unsigned char* src_ = gb + (size_t)(nn) * UNIT_BYTES; LAS unsigned char* dst_ = lds + SC_A + ((nn) & 1) * A_BYTES; \
        _Pragma("unroll") for (int f_ = 0; f_ < 8; ++f_) __builtin_amdgcn_global_load_lds((const unsigned*)(src_ + (lw + 4 * f_) * 1024 + lane * 16), (LAS unsigned*)(dst_ + (lw + 4 * f_) * 1024), 16, 0, 0); \
        _Pragma("unroll") for (int f_ = 0; f_ < 4; ++f_) __builtin_amdgcn_global_load_lds((const unsigned*)(src_ + OFF_U + (lw + 4 * f_) * 1024 + lane * 16), (LAS unsigned*)(dst_ + 32768 + (lw + 4 * f_) * 1024), 16, 0, 0); } while (0)
#define DMA_B(nn) do { const unsigned char* src_ = gb + (size_t)(nn) * UNIT_BYTES; LAS unsigned char* dst_ = lds + SC_B + ((nn) & 1) * B_BYTES; const int fa_ = (lw + 4 < 6) ? lw + 4 : lw; \
        _Pragma("unroll") for (int f_ = 0; f_ < 4; ++f_) __builtin_amdgcn_global_load_lds((const unsigned*)(src_ + OFF_KE + (lw + 4 * f_) * 1024 + lane * 16), (LAS unsigned*)(dst_ + (lw + 4 * f_) * 1024), 16, 0, 0); \
        __builtin_amdgcn_global_load_lds((const unsigned*)(src_ + OFF_ATT + lw * 1024 + lane * 16), (LAS unsigned*)(dst_ + 16384 + lw * 1024), 16, 0, 0); \
        __builtin_amdgcn_global_load_lds((const unsigned*)(src_ + OFF_ATT + fa_ * 1024 + lane * 16), (LAS unsigned*)(dst_ + 16384 + fa_ * 1024), 16, 0, 0); } while (0)
        DMA_A(0); DMA_B(0); DMA_A(1);
        asm volatile("s_waitcnt vmcnt(12) lgkmcnt(0)" ::: "memory"); SCAN_BAR();
        for (int n = 0; n < 64; ++n) {
            v4u orow[4]; float ssq = 0.f;
            if (n > 0) {
#pragma unroll
                for (int i = 0; i < 4; ++i) orow[i] = *(const LAS v4u*)(lds + SC_OST + (16 * lw + 4 * i + (lane >> 4)) * OST_STRIDE + 16 * (lane & 15));
                const LAS float* sx = (const LAS float*)(lds + SC_SSX + ((n - 1) & 1) * 1024) + 16 * lw + (lane & 15); ssq = (sx[0] + sx[64]) + (sx[128] + sx[192]);
            }
            if (n + 1 < 64) DMA_B(n + 1);
            if (n > 0) {
                bf16* yr = yrow + (size_t)((n - 1) * 64) * D;
#pragma unroll
                for (int i = 0; i < 4; ++i) *(v4u*)(yr + (size_t)(4 * i) * D) = orow[i];
                if (lane < 16) sso[(size_t)((n - 1) * 64) * 16] = ssq;
            }
            if (n >= 2 && n + 1 < 64) asm volatile("s_waitcnt vmcnt(28) lgkmcnt(0)" ::: "memory"); else asm volatile("s_waitcnt vmcnt(0) lgkmcnt(0)" ::: "memory");
            SCAN_BAR();
            if (n + 2 < 64) DMA_A(n + 2);
            if (n >= 1 && n + 2 < 64) asm volatile("s_waitcnt vmcnt(23)" ::: "memory"); else asm volatile("s_waitcnt vmcnt(0)" ::: "memory");
            SCAN_BAR();
        }
        {
            v4u orow[4];
#pragma unroll
            for (int i = 0; i < 4; ++i) orow[i] = *(const LAS v4u*)(lds + SC_OST + (16 * lw + 4 * i + (lane >> 4)) * OST_STRIDE + 16 * (lane & 15));
            bf16* yr = yrow + (size_t)(63 * 64) * D;
#pragma unroll
            for (int i = 0; i < 4; ++i) *(v4u*)(yr + (size_t)(4 * i) * D) = orow[i];
            const LAS float* sx = (const LAS float*)(lds + SC_SSX + (63 & 1) * 1024) + 16 * lw + (lane & 15);
            if (lane < 16) sso[(size_t)(63 * 64) * 16] = (sx[0] + sx[64]) + (sx[128] + sx[192]);
        }
#undef DMA_A
#undef DMA_B
        return;
    }
    const float decv = ((const float*)(ws + WS_BETA))[bh * 64 + lane];
    f32x16 S[4];
#pragma unroll
    for (int d = 0; d < 4; ++d) S[d] = zero16();
    asm volatile("s_waitcnt vmcnt(0) lgkmcnt(0)" ::: "memory"); SCAN_BAR();
    for (int n = 0; n < 64; ++n) {
        const LAS unsigned char* buf = lds + SC_A + (n & 1) * A_BYTES; const LAS unsigned char* bbuf = lds + SC_B + (n & 1) * B_BYTES; const LAS unsigned char* ubuf = buf + 32768 + (w * 2) * 1024 + lane * 16;
        const float dec0 = __shfl(decv, n);
        f32x16 P0 = unpack16(*(const LAS bf16x8*)(ubuf), *(const LAS bf16x8*)(ubuf + 1024)), P1 = unpack16(*(const LAS bf16x8*)(ubuf + 8192), *(const LAS bf16x8*)(ubuf + 8192 + 1024));
        f32x16 O0 = zero16(), O1 = zero16();
#define FR(off, idx) (*(const LAS bf16x8*)(buf + (off) + (idx) * 1024 + lane * 16))
#define FB(off, idx) (*(const LAS bf16x8*)(bbuf + (off) + (idx) * 1024 + lane * 16))
        bf16x8 fa[4], fb[4];
#define LDPO(dst, t) do { (dst)[0] = FR(0, (((t) >> 1) * 2 + 0) * 2 + ((t) & 1)); (dst)[1] = FR(0, (((t) >> 1) * 2 + 1) * 2 + ((t) & 1)); \
                          (dst)[2] = FR(16384, (((t) >> 1) * 2 + 0) * 2 + ((t) & 1)); (dst)[3] = FR(16384, (((t) >> 1) * 2 + 1) * 2 + ((t) & 1)); __builtin_amdgcn_sched_barrier(0); } while (0)
#define MMPO(src, t) do { const bf16x8 sb = PACK_STEP(S[(t) >> 1], (t) & 1); P0 = MFMA32((src)[0], sb, P0); P1 = MFMA32((src)[1], sb, P1); O0 = MFMA32(sb, (src)[2], O0); O1 = MFMA32(sb, (src)[3], O1); __builtin_amdgcn_sched_barrier(0); } while (0)
        LDPO(fa, 0);
        LDPO(fb, 1); MMPO(fa, 0); LDPO(fa, 2); MMPO(fb, 1); LDPO(fb, 3); MMPO(fa, 2); LDPO(fa, 4); MMPO(fb, 3);
        LDPO(fb, 5); MMPO(fa, 4); LDPO(fa, 6); MMPO(fb, 5); LDPO(fb, 7); MMPO(fa, 6); MMPO(fb, 7);
        float dec = dec0; asm volatile("" : "+v"(dec) : "v"(P0[15]), "v"(P1[15]));
        const bf16x8 v00 = PACK_STEP(P0, 0), v01 = PACK_STEP(P0, 1), v10 = PACK_STEP(P1, 0), v11 = PACK_STEP(P1, 1);
        asm volatile("s_waitcnt lgkmcnt(0)" ::: "memory"); SCAN_BAR();
#define LDKE(dst, d) do { (dst)[0] = FB(0, ((d) * 2 + 0) * 2 + 0); (dst)[1] = FB(0, ((d) * 2 + 0) * 2 + 1); (dst)[2] = FB(0, ((d) * 2 + 1) * 2 + 0); (dst)[3] = FB(0, ((d) * 2 + 1) * 2 + 1); __builtin_amdgcn_sched_barrier(0); } while (0)
#define MMKE(src, d) do { _Pragma("unroll") for (int i_ = 0; i_ < 16; ++i_) S[d][i_] *= dec; \
        S[d] = MFMA32((src)[0], v00, S[d]); S[d] = MFMA32((src)[1], v01, S[d]); S[d] = MFMA32((src)[2], v10, S[d]); S[d] = MFMA32((src)[3], v11, S[d]); __builtin_amdgcn_sched_barrier(0); } while (0)
        LDKE(fa, 0);
        LDKE(fb, 1); MMKE(fa, 0); LDKE(fa, 2); MMKE(fb, 1); LDKE(fb, 3); MMKE(fa, 2);
        const bf16x8 at0 = FB(16384, 0), at1 = FB(16384, 1), at2 = FB(16384, 2), at3 = FB(16384, 3), at4 = FB(16384, 4), at5 = FB(16384, 5); __builtin_amdgcn_sched_barrier(0); MMKE(fb, 3);
        O0 = MFMA32(v00, at0, O0); O0 = MFMA32(v01, at1, O0);
        O1 = MFMA32(v00, at2, O1); O1 = MFMA32(v01, at3, O1);
        O1 = MFMA32(v10, at4, O1); O1 = MFMA32(v11, at5, O1);
#undef LDPO
#undef MMPO
#undef LDKE
#undef MMKE
#undef FR
#undef FB
        { float q0 = 0.f, q1 = 0.f;
#pragma unroll
          for (int i = 0; i < 16; ++i) { q0 += O0[i] * O0[i]; q1 += O1[i] * O1[i]; }
          q0 += __shfl_xor(q0, 32); q1 += __shfl_xor(q1, 32);
          ((LAS float*)(lds + SC_SSX + (n & 1) * 1024))[w * 64 + lane] = h ? q1 : q0; }
        { LAS unsigned char* ot = lds + SC_OST + c * OST_STRIDE + (32 * w + 4 * h) * 2;
#pragma unroll
          for (int g4 = 0; g4 < 4; ++g4) { v2u a, bq; a.x = cvtpk(O0[4 * g4], O0[4 * g4 + 1]); a.y = cvtpk(O0[4 * g4 + 2], O0[4 * g4 + 3]); bq.x = cvtpk(O1[4 * g4], O1[4 * g4 + 1]); bq.y = cvtpk(O1[4 * g4 + 2], O1[4 * g4 + 3]);
              *(LAS v2u*)(ot + 16 * g4) = a; *(LAS v2u*)(ot + 32 * OST_STRIDE + 16 * g4) = bq; } }
        asm volatile("s_waitcnt lgkmcnt(0)" ::: "memory"); SCAN_BAR();
    }
}
#define XB_TMO      128
#define XB_XCNT(j)  (256  + 64 * (j))
#define XB_XSUB(j)  (1280 + 64 * (j))
#define XB_XGEN(j)  (2304 + 64 * (j))
#define XB_TOP      3328
#define XB_TOPGEN   3392
#define XCD_BAR_WORDS 3456
#define XB_SPIN_CAP (1u << 18)

__device__ __forceinline__ unsigned xb_ld(unsigned* p)              { return __hip_atomic_load(p, __ATOMIC_RELAXED, __HIP_MEMORY_SCOPE_AGENT); }
__device__ __forceinline__ unsigned xb_add(unsigned* p, unsigned v) { return __hip_atomic_fetch_add(p, v, __ATOMIC_RELAXED, __HIP_MEMORY_SCOPE_AGENT); }
__device__ __forceinline__ unsigned xb_xcc_id() { return (unsigned)__builtin_amdgcn_s_getreg((3 << 11) | 20) & 0xFu; }
#define XB_SPIN(cond, bar) do { unsigned _sp = 0; while (cond) { __builtin_amdgcn_s_sleep(1); \
    if ((++_sp & 255u) == 0u) { if (xb_ld(&(bar)[XB_TMO])) break; if (_sp > XB_SPIN_CAP) { atomicAdd(&(bar)[XB_TMO], 1u); break; } } } } while (0)

struct XcdBarrier {
    unsigned* bar; unsigned x;
    volatile LAS unsigned* st;
};

__device__ __forceinline__ XcdBarrier xcd_barrier_post(unsigned* bar, volatile LAS unsigned* st) {
    XcdBarrier b; b.bar = bar; b.x = xb_xcc_id(); b.st = st;
    if (threadIdx.x == 0) (void)xb_add(&bar[XB_XCNT(b.x)], 1u);
    return b;
}
__device__ __forceinline__ void xcd_barrier_complete(unsigned* bar, unsigned x, unsigned& nloc, unsigned& nx) {
    const unsigned G = gridDim.x * gridDim.y * gridDim.z;
    unsigned sum, cnt, mine, sp = 0u;
    for (;;) {
        sum = 0u; cnt = 0u; mine = 0u;
#pragma unroll
        for (unsigned j = 0; j < 16; ++j) { const unsigned c = xb_ld(&bar[XB_XCNT(j)]); sum += c; cnt += (c > 0u) ? 1u : 0u; mine = (j == x) ? c : mine; }
        if (sum == G) break;
        __builtin_amdgcn_s_sleep(1);
        if ((++sp & 255u) == 0u) { if (xb_ld(&bar[XB_TMO])) break; if (sp > XB_SPIN_CAP) { atomicAdd(&bar[XB_TMO], 1u); break; } }
    }
    nloc = mine > 0u ? mine : 1u; nx = cnt > 0u ? cnt : 1u;
}

__device__ __forceinline__ void xcd_barrier(const XcdBarrier& b) {
    asm volatile("s_waitcnt vmcnt(0)" ::: "memory");
    __syncthreads();
    if (threadIdx.x == 0) {
        unsigned* bar = b.bar;
        __builtin_amdgcn_s_waitcnt(0);
        unsigned nloc = b.st[0], nx = b.st[1];
        if (nloc == 0u) { xcd_barrier_complete(bar, b.x, nloc, nx); b.st[0] = nloc; b.st[1] = nx; }
        const unsigned old = xb_add(&bar[XB_XSUB(b.x)], 1u);
        const unsigned gen = old / nloc;
        if (old + 1u == (gen + 1u) * nloc) {
            __builtin_amdgcn_fence(__ATOMIC_RELEASE, "agent");
            asm volatile("s_waitcnt vmcnt(0)" ::: "memory");
            const unsigned og = xb_add(&bar[XB_TOP], 1u);
            const unsigned tg = og / nx;
            if (og + 1u == (tg + 1u) * nx) xb_add(&bar[XB_TOPGEN], 1u);
            else XB_SPIN(xb_ld(&bar[XB_TOPGEN]) == tg, bar);
            __builtin_amdgcn_fence(__ATOMIC_ACQUIRE, "agent");
            xb_add(&bar[XB_XGEN(b.x)], 1u);
            asm volatile("s_waitcnt vmcnt(0)" ::: "memory");
        } else {
            XB_SPIN(xb_ld(&bar[XB_XGEN(b.x)]) == gen, bar);
            __builtin_amdgcn_fence(__ATOMIC_ACQUIRE, "agent");
            asm volatile("s_waitcnt vmcnt(0)" ::: "memory");
        }
    }
    __syncthreads();
}
constexpr int RING_BYTES = 131072;
constexpr int MISC_OFF = 162880;
constexpr int LDS_BYTES = 163840;
constexpr int CW_BAR = 4096;
constexpr size_t CTL_ZERO_BYTES = 1 * MiB;

#define GRID_BAR() xcd_barrier(bar)
#define WSB(off) ((bf16*)(wsp(T) + (off)))
#define OPQ(x) opq_s((int)(x))
DI int opq_s(int x) { asm volatile("" : "+s"(x)); return x; }
template <int l> DI void layer_body(PTab T, LAS unsigned char* lds, const XcdBarrier& bar) {
        ph_rmsnorm_bf16(l == 0 ? inp(T, I_X) : outp(T), inp(T, I_NMW) + l * D, WSB(WS_H));
        GRID_BAR();
        ph_ba(T, l, lds);
        { pg8::Gemm g{WSB(WS_H), WSB(WS_WIN) + (size_t)(l & 1) * NIN * D, M, NPROJ, D, D, D, 0};
          pg8::StaticOrderIn S; S.init(M, NPROJ, OPQ(gridDim.x), OPQ(blockIdx.x)); pg8::EpiProj E{WSB(WS_PROJ), NPO};
          pg8::gemm_phase<pg8::EpiProj, pg8::StaticOrderIn, true, true>(lds, g, S, E); }
        GRID_BAR();
        ph_pooled(T);
        ph_gdn_chunks(T, l, lds);
        GRID_BAR();
        if (blockIdx.x < BATCH * NH) ph_gdn_scan(T, lds, blockIdx.x);
        else { pg8::Gemm g{WSB(WS_POOLED), WSB(WS_WPL) + (size_t)(l & 1) * D * 512, M, D, 512, D, 512, 2};
          pg8::StaticOrder S; S.init(M, D, OPQ(gridDim.x) - BATCH * NH, OPQ(blockIdx.x) - BATCH * NH); pg8::EpiPool E{WSB(WS_YB), D, inp(T, I_PS) + l * D, WSB(WS_PROJ) + C_GB, NPO};
          pg8::gemm_phase<pg8::EpiPool, pg8::StaticOrder, true, true>(lds, g, S, E);
          __syncthreads(); ph_convert(T, lds, l * IT_LAYER + IT_FIRST, l + 1 < DEPTH ? (l + 1) * IT_LAYER + IT_FIRST : DEPTH * IT_LAYER, BATCH * NH); }
        GRID_BAR();
        ph_mix(T, l);
        GRID_BAR();
        { pg8::Gemm g{WSB(WS_MIXED), WSB(WS_WOUT) + (size_t)(l & 1) * D * D, M, D, D, D, D, 0};
          pg8::StaticOrder S; S.init(M, D, OPQ(gridDim.x), OPQ(blockIdx.x)); pg8::EpiResF32 E{l == 0 ? inp(T, I_X) : outp(T), outp(T), D};
          pg8::gemm_phase<pg8::EpiResF32, pg8::StaticOrder, true, true>(lds, g, S, E); }
        GRID_BAR();
        ph_rmsnorm_bf16(outp(T), inp(T, I_NFW) + l * D, WSB(WS_H));
        GRID_BAR();
        { pg8::Gemm g{WSB(WS_H), WSB(WS_WUP) + (size_t)(l & 1) * 2 * DFF * D, M, 2 * DFF, D, D, D, 0};
          pg8::StaticOrder S; S.init(M, 2 * DFF, OPQ(gridDim.x), OPQ(blockIdx.x));
          pg8::EpiGlu E{WSB(WS_BIG2), inp(T, I_CFW) + (size_t)l * 3 * DFF, inp(T, I_CFB) + (size_t)l * DFF, (float*)(wsp(T) + WS_EDGE), (LAS float*)(lds + RING_BYTES), DFF};
          pg8::gemm_phase<pg8::EpiGlu, pg8::StaticOrder, true, true>(lds, g, S, E); }
        GRID_BAR();
        ph_glu_fix(T, l);
        GRID_BAR();
        { pg8::Gemm g{WSB(WS_BIG2), WSB(WS_WDN) + (size_t)(l & 1) * D * DFF, M, D, DFF, DFF, DFF, 0};
          pg8::StaticOrder S; S.init(M, D, OPQ(gridDim.x), OPQ(blockIdx.x)); pg8::EpiResF32 E{outp(T), outp(T), D};
          pg8::gemm_phase<pg8::EpiResF32, pg8::StaticOrder, true, true>(lds, g, S, E); }
        GRID_BAR();
}
static_assert(SC_END <= MISC_OFF && L_VEC + 5 * 256 <= MISC_OFF && RING_BYTES + 4096 <= MISC_OFF, "LDS map");
constexpr int TAB_OFF = MISC_OFF + 256;
__global__ void __launch_bounds__(NTHREADS, 2) mega_fwd(Ctx c) {
    extern __shared__ __attribute__((aligned(16))) unsigned char lds_raw[];
    LAS unsigned char* lds = (LAS unsigned char*)lds_raw;
    for (int u = threadIdx.x; u < (LDS_BYTES - MISC_OFF) / 4; u += NTHREADS) ((LAS unsigned*)(lds + MISC_OFF))[u] = 0u;
    __syncthreads();
    if (threadIdx.x < 16) ((LAS unsigned long long*)(lds + TAB_OFF))[threadIdx.x] = (unsigned long long)c.in[threadIdx.x];
    if (threadIdx.x == 16) ((LAS unsigned long long*)(lds + TAB_OFF))[16] = (unsigned long long)c.out;
    if (threadIdx.x == 17) ((LAS unsigned long long*)(lds + TAB_OFF))[17] = (unsigned long long)c.ws;
    __syncthreads();
    const PTab T = (PTab)(lds + TAB_OFF);
    XcdBarrier bar = xcd_barrier_post((unsigned*)(wsp(T) + WS_CTL) + CW_BAR, (volatile LAS unsigned*)(lds + MISC_OFF) + 8);

    ph_convert(T, lds, 0, IT_FIRST, 0);
    GRID_BAR();
    layer_body<0>(T, lds, bar); layer_body<1>(T, lds, bar); layer_body<2>(T, lds, bar); layer_body<3>(T, lds, bar);
    const bool poison = __hip_atomic_load((unsigned*)(wsp(T) + WS_CTL) + CW_BAR + XB_TMO, __ATOMIC_RELAXED, __HIP_MEMORY_SCOPE_AGENT) != 0u;
    ph_rmsnorm_f32(outp(T), inp(T, I_NFIN), outp(T));
    if (poison) { asm volatile("s_waitcnt vmcnt(0)" ::: "memory"); float* X = outp(T); const float q = __builtin_nanf(""); for (size_t e = (size_t)blockIdx.x * NTHREADS + threadIdx.x; e < (size_t)M * D; e += (size_t)gridDim.x * NTHREADS) X[e] = q; }
#undef GRID_BAR
#undef WSB
}

extern "C" void kernel_launch(void* const* d_in, const int* in_sizes, int n_in, void* d_out, int out_size, void* d_ws, size_t ws_size, hipStream_t stream) {
    static int grid = 0;
    if (grid == 0) {
        if (n_in != 16 || out_size != M * D || ws_size < WS_END) { fprintf(stderr, "kernel_launch: unexpected shapes (n_in %d, out %d, ws %zu)\n", n_in, out_size, ws_size); grid = -1; return; }
        int dev = 0, cus = 0, per_cu = 0;
        if (hipGetDevice(&dev) != hipSuccess || hipDeviceGetAttribute(&cus, hipDeviceAttributeMultiprocessorCount, dev) != hipSuccess) { grid = -1; return; }
        if (hipFuncSetAttribute((const void*)mega_fwd, hipFuncAttributeMaxDynamicSharedMemorySize, LDS_BYTES) != hipSuccess) { fprintf(stderr, "kernel_launch: hipFuncSetAttribute failed\n"); grid = -1; return; }
        if (hipOccupancyMaxActiveBlocksPerMultiprocessor(&per_cu, (const void*)mega_fwd, NTHREADS, LDS_BYTES) != hipSuccess || per_cu < 1) fprintf(stderr, "kernel_launch: occupancy query says %d\n", per_cu);
        (void)hipGetLastError();
        grid = cus;
    }
    if (grid < 0) return;
    if (hipMemsetAsync((char*)d_ws + WS_CTL, 0, CTL_ZERO_BYTES, stream) != hipSuccess) return;
    Ctx c{};
    for (int i = 0; i < 16; ++i) c.in[i] = (const float*)d_in[i];
    c.out = (float*)d_out; c.ws = (unsigned char*)d_ws;
    hipLaunchKernelGGL(mega_fwd, dim3(grid), dim3(NTHREADS), LDS_BYTES, stream, c);
}
```

```cpp
#include <hip/hip_runtime.h>
#include <cstdio>
#include <cstdint>

namespace pg8 {
#define PG8_LAS __attribute__((address_space(3)))
typedef unsigned short bf16_t;
typedef short bf16x8 __attribute__((ext_vector_type(8)));
typedef float f32x4 __attribute__((ext_vector_type(4)));
typedef unsigned u32x4 __attribute__((ext_vector_type(4)));
constexpr int BM = 256, BK = 64, HALF = 128, HTB = HALF * BK * 2  , STAGE_BYTES = 8 * HTB, NXCD = 8, WGM = 8;

__host__ __device__ __forceinline__ int lds_byte(int r, int c) { const int st = (r >> 4) * 2 + (c >> 5), rr = r & 15, cc = c & 31, ob = rr * 64 + cc * 2; return st * 1024 + (ob ^ (((ob >> 9) & 1) << 5)); }
__host__ __device__ __forceinline__ void stage_rc(int b, int& R, int& C) { const int st = b / 1024, sb = b % 1024, swz = sb ^ (((sb >> 9) & 1) << 5); R = (st >> 1) * 16 + swz / 64; C = (st & 1) * 32 + (swz % 64) / 2; }
__host__ __device__ __forceinline__ int perm32(int rho) { const int n = rho >> 4, i = rho & 15; return 8 * (i >> 2) + 4 * n + (i & 3); }

struct Unit { int pm, pn; };
struct Gemm { const bf16_t* A; const bf16_t* Bt; int M, N, K, lda, ldb, agrp; };

struct StaticOrder {
    int nM, nN, nwg, G, c;
    __host__ __device__ void init(int M, int N, int G_, int c_) { nM = M / BM; nN = N / BM; nwg = nM * nN; G = G_; c = c_; }
    __host__ __device__ bool next(int i, Unit& u) const {
        const long L = (long)i * G + c; if (L >= nwg) return false;
        int wgid = (int)L; { const int q = nwg / NXCD, r = nwg % NXCD, xcd = wgid % NXCD, off = wgid / NXCD; wgid = (xcd < r ? xcd * (q + 1) : r * (q + 1) + (xcd - r) * q) + off; }
        const int nig = WGM * nN, gid = wgid / nig, fm = gid * WGM, gsz = (nM - fm) < WGM ? (nM - fm) : WGM;
        u.pm = fm + ((wgid % nig) % gsz); u.pn = (wgid % nig) / gsz; return true;
    }
    __device__ __forceinline__ void a_ready(const Unit&) const {}
    __device__ __forceinline__ void done(const Unit&) const {}
};
struct StaticOrderIn : StaticOrder {
    __host__ __device__ bool next(int i, Unit& u) const { const bool r = StaticOrder::next(i, u);
        if (r) { const int s = u.pn; u.pn = s < 16 ? 24 + s : s < 24 ? 32 + s : s < 48 ? s - 24 : s - 8; } return r; }
};

__device__ __forceinline__ unsigned cvt_pk_bf16(float lo, float hi) { unsigned r; asm volatile("v_cvt_pk_bf16_f32 %0, %1, %2" : "=v"(r) : "v"(lo), "v"(hi)); return r; }
typedef float f32x2 __attribute__((ext_vector_type(2)));

struct EpiBf16 {
    static constexpr bool PERM = true, AFTER_DRAIN = false;
    bf16_t* O; int ldc;
    __device__ __forceinline__ void operator()(const f32x4 (&acc)[2][2][4][2], const Unit& u, int wr, int wc, int fr, int fq) const {
        const int row0 = u.pm * BM + wr * 64 + fr; const int col0 = u.pn * BM + wc * 32 + 8 * fq;
#pragma unroll
        for (int ai = 0; ai < 2; ++ai)
#pragma unroll
            for (int m = 0; m < 4; ++m) { bf16_t* rowp = O + (size_t)(row0 + ai * HALF + m * 16) * ldc + col0;
#pragma unroll
                for (int bj = 0; bj < 2; ++bj) { const f32x4 v0 = acc[ai][bj][m][0], v1 = acc[ai][bj][m][1];
                    u32x4 w; w.x = cvt_pk_bf16(v0[0], v0[1]); w.y = cvt_pk_bf16(v0[2], v0[3]); w.z = cvt_pk_bf16(v1[0], v1[1]); w.w = cvt_pk_bf16(v1[2], v1[3]);
                    *(u32x4*)(rowp + bj * HALF) = w; } }
    }
};
struct EpiProj {
    static constexpr bool PERM = true, AFTER_DRAIN = false;
    bf16_t* O; int ldc;
    __device__ __forceinline__ void operator()(const f32x4 (&acc)[2][2][4][2], const Unit& u, int wr, int wc, int fr, int fq) const {
        const int row0 = u.pm * BM + wr * 64 + fr; const int lc = wc * 32 + 8 * fq;
        if (u.pn >= 24 && u.pn < 40) {
            const int col0 = 6144 + 128 * (u.pn - 24) + lc;
#pragma unroll
            for (int ai = 0; ai < 2; ++ai)
#pragma unroll
                for (int m = 0; m < 4; ++m) { u32x4 w;
#pragma unroll
                    for (int n = 0; n < 2; ++n) { const f32x4 z = acc[ai][0][m][n], g = acc[ai][1][m][n]; f32x4 r;
#pragma unroll
                        for (int e = 0; e < 4; ++e) r[e] = z[e] * __builtin_amdgcn_rcpf((1.0f + __builtin_amdgcn_exp2f(-1.4426950408889634f * z[e])) * (1.0f + __builtin_amdgcn_exp2f(-1.4426950408889634f * g[e])));
                        const unsigned lo = cvt_pk_bf16(r[0], r[1]), hi = cvt_pk_bf16(r[2], r[3]); if (n == 0) { w.x = lo; w.y = hi; } else { w.z = lo; w.w = hi; } }
                    *(u32x4*)(O + (size_t)(row0 + ai * HALF + m * 16) * ldc + col0) = w; }
        } else {
            const int col0 = (u.pn < 24 ? 256 * u.pn : 8192 + 256 * (u.pn - 40)) + lc;
#pragma unroll
            for (int ai = 0; ai < 2; ++ai)
#pragma unroll
                for (int m = 0; m < 4; ++m) { bf16_t* rowp = O + (size_t)(row0 + ai * HALF + m * 16) * ldc + col0;
#pragma unroll
                    for (int bj = 0; bj < 2; ++bj) { const f32x4 v0 = acc[ai][bj][m][0], v1 = acc[ai][bj][m][1];
                        u32x4 w; w.x = cvt_pk_bf16(v0[0], v0[1]); w.y = cvt_pk_bf16(v0[2], v0[3]); w.z = cvt_pk_bf16(v1[0], v1[1]); w.w = cvt_pk_bf16(v1[2], v1[3]);
                        *(u32x4*)(rowp + bj * HALF) = w; } }
        }
    }
};
struct EpiPool {
    static constexpr bool PERM = true, AFTER_DRAIN = false;
    bf16_t* O; int ldc; const float* scale; const bf16_t* gate; int ldg;
    __device__ __forceinline__ void operator()(const f32x4 (&acc)[2][2][4][2], const Unit& u, int wr, int wc, int fr, int fq) const {
        const int row0 = u.pm * BM + wr * 64 + fr; const int col0 = u.pn * BM + wc * 32 + 8 * fq;
        f32x4 sc[2][2];
#pragma unroll
        for (int bj = 0; bj < 2; ++bj) { sc[bj][0] = *(const f32x4*)(scale + col0 + bj * HALF); sc[bj][1] = *(const f32x4*)(scale + col0 + bj * HALF + 4); }
#pragma unroll
        for (int ai = 0; ai < 2; ++ai)
#pragma unroll
            for (int m = 0; m < 4; ++m) { const size_t row = (size_t)(row0 + ai * HALF + m * 16); bf16_t* rowp = O + row * ldc + col0;
                u32x4 gt[2];
#pragma unroll
                for (int bj = 0; bj < 2; ++bj) gt[bj] = *(const u32x4*)(gate + row * ldg + col0 + bj * HALF);
#pragma unroll
                for (int bj = 0; bj < 2; ++bj) { f32x4 v0 = acc[ai][bj][m][0] * sc[bj][0], v1 = acc[ai][bj][m][1] * sc[bj][1];
#pragma unroll
                    for (int e = 0; e < 2; ++e) { const float g0 = __uint_as_float(gt[bj][e] << 16), g1 = __uint_as_float(gt[bj][e] & 0xffff0000u), g2 = __uint_as_float(gt[bj][2 + e] << 16), g3 = __uint_as_float(gt[bj][2 + e] & 0xffff0000u);
                        v0[2 * e] *= __builtin_amdgcn_rcpf(1.0f + __builtin_amdgcn_exp2f(-1.4426950408889634f * g0)); v0[2 * e + 1] *= __builtin_amdgcn_rcpf(1.0f + __builtin_amdgcn_exp2f(-1.4426950408889634f * g1));
                        v1[2 * e] *= __builtin_amdgcn_rcpf(1.0f + __builtin_amdgcn_exp2f(-1.4426950408889634f * g2)); v1[2 * e + 1] *= __builtin_amdgcn_rcpf(1.0f + __builtin_amdgcn_exp2f(-1.4426950408889634f * g3)); }
                    u32x4 w; w.x = cvt_pk_bf16(v0[0], v0[1]); w.y = cvt_pk_bf16(v0[2], v0[3]); w.z = cvt_pk_bf16(v1[0], v1[1]); w.w = cvt_pk_bf16(v1[2], v1[3]);
                    *(u32x4*)(rowp + bj * HALF) = w; } }
    }
};
struct EpiResF32 {
    static constexpr bool PERM = false, AFTER_DRAIN = false;
    const float* base; float* out; int ldc;
    __device__ __forceinline__ void operator()(const f32x4 (&acc)[2][2][4][2], const Unit& u, int wr, int wc, int fr, int fq) const {
        const int row0 = u.pm * BM + wr * 64 + fr, col0 = u.pn * BM + wc * 32 + 4 * fq;
#pragma unroll
        for (int ai = 0; ai < 2; ++ai) {
            f32x4 bs[4][2][2];
#pragma unroll
            for (int m = 0; m < 4; ++m) { const size_t off = (size_t)(row0 + ai * HALF + m * 16) * ldc + col0;
#pragma unroll
                for (int bj = 0; bj < 2; ++bj)
#pragma unroll
                    for (int n = 0; n < 2; ++n) bs[m][bj][n] = *(const f32x4*)(base + off + bj * HALF + n * 16); }
#pragma unroll
            for (int m = 0; m < 4; ++m) { const size_t off = (size_t)(row0 + ai * HALF + m * 16) * ldc + col0;
#pragma unroll
                for (int bj = 0; bj < 2; ++bj)
#pragma unroll
                    for (int n = 0; n < 2; ++n) *(f32x4*)(out + off + bj * HALF + n * 16) = bs[m][bj][n] + acc[ai][bj][m][n]; }
            asm volatile("" ::: "memory"); }
    }
};

__device__ __forceinline__ f32x2 gelu_pk(f32x2 v) {
    const f32x2 av = __builtin_elementwise_abs(v), d = av * 0.2316418882f + 1.0f;
    f32x2 t; t.x = __builtin_amdgcn_rcpf(d.x); t.y = __builtin_amdgcn_rcpf(d.y);
    f32x2 q = t * 0.5307027145f + (-0.7265760135f); q = q * t + 0.7107068705f; q = q * t + (-0.142248368f); q = q * t + 0.127414796f; q = q * t;
    const f32x2 s = (v * v) * (-0.72134752044f);
    f32x2 e; e.x = __builtin_amdgcn_exp2f(s.x); e.y = __builtin_amdgcn_exp2f(s.y);
    const f32x2 m = v * (q * e), r = v - m;
    f32x2 o; o.x = v.x < 0.f ? m.x : r.x; o.y = v.y < 0.f ? m.y : r.y; return o;
}
template <int N> __device__ __forceinline__ float row_ror(float x) { return __builtin_bit_cast(float, __builtin_amdgcn_update_dpp(0, __builtin_bit_cast(int, x), 0x120 + N, 0xf, 0xf, false)); }
struct EpiGlu {
    static constexpr bool PERM = true, AFTER_DRAIN = false;
    bf16_t* ACT; const float* cw; const float* cb; float* edge; PG8_LAS float* xb; int dff;
    __device__ __forceinline__ void operator()(const f32x4 (&acc)[2][2][4][2], const Unit& u, int wr, int wc, int fr, int fq) const {
        const int f0 = u.pn * 128 + wc * 32 + 8 * fq;
        if (fr >= 14) {
#pragma unroll
            for (int ai = 0; ai < 2; ++ai) { PG8_LAS f32x4* p = (PG8_LAS f32x4*)(xb + ((((wr * 2 + ai) * 4 + wc) * 2 + (fr - 14)) * 32 + 8 * fq)); p[0] = acc[ai][0][3][0]; p[1] = acc[ai][0][3][1]; }
        }
        asm volatile("s_waitcnt lgkmcnt(0)" ::: "memory"); __builtin_amdgcn_s_barrier(); asm volatile("" ::: "memory");
        f32x4 w0[2], w1[2], w2[2], bb[2];
#pragma unroll
        for (int n = 0; n < 2; ++n) { w0[n] = *(const f32x4*)(cw + f0 + 4 * n); w1[n] = *(const f32x4*)(cw + dff + f0 + 4 * n); w2[n] = *(const f32x4*)(cw + 2 * dff + f0 + 4 * n); bb[n] = *(const f32x4*)(cb + f0 + 4 * n); }
        const bool seq_start = (u.pm & 15) == 0;
#pragma unroll
        for (int ai = 0; ai < 2; ++ai) {
            f32x4 pr1[2], pr2[2];
            if (wr == 1 || ai == 1) { const int swr = (wr == 1) ? 0 : 1, sai = (wr == 1) ? ai : 0; const PG8_LAS f32x4* p = (const PG8_LAS f32x4*)(xb + ((((swr * 2 + sai) * 4 + wc) * 2) * 32 + 8 * fq));
                const f32x4 a0 = p[0], a1 = p[1], b0 = p[8], b1 = p[9]; pr1[0] = b0; pr1[1] = b1; pr2[0] = (fr == 0) ? a0 : b0; pr2[1] = (fr == 0) ? a1 : b1; }
            else { pr1[0] = pr1[1] = pr2[0] = pr2[1] = (f32x4){0.f, 0.f, 0.f, 0.f}; }
            const bool defer_blk = (ai == 0) && (wr == 0) && !seq_start;
#pragma unroll
            for (int m = 0; m < 4; ++m) {
                const int row = u.pm * BM + ai * HALF + wr * 64 + m * 16 + fr; u32x4 w;
#pragma unroll
                for (int n = 0; n < 2; ++n) { const f32x4 g = acc[ai][0][m][n], up = acc[ai][1][m][n]; f32x4 r1, r2, a;
                    r1[0] = row_ror<1>(g[0]); r1[1] = row_ror<1>(g[1]); r1[2] = row_ror<1>(g[2]); r1[3] = row_ror<1>(g[3]);
                    r2[0] = row_ror<2>(g[0]); r2[1] = row_ror<2>(g[1]); r2[2] = row_ror<2>(g[2]); r2[3] = row_ror<2>(g[3]);
#pragma unroll
                    for (int e = 0; e < 4; ++e) { const float p1 = (fr >= 1) ? r1[e] : pr1[n][e], p2 = (fr >= 2) ? r2[e] : pr2[n][e]; a[e] = w0[n][e] * p2 + w1[n][e] * p1 + w2[n][e] * g[e] + bb[n][e]; }
                    pr1[n] = r1; pr2[n] = r2;
                    const f32x2 x0 = gelu_pk((f32x2){a[0], a[1]}), x1 = gelu_pk((f32x2){a[2], a[3]});
                    const unsigned lo = cvt_pk_bf16(x0.x * up[0], x0.y * up[1]), hi = cvt_pk_bf16(x1.x * up[2], x1.y * up[3]);
                    if (n == 0) { w.x = lo; w.y = hi; } else { w.z = lo; w.w = hi; } }
                if (defer_blk && m == 0 && fr < 2) { float* eg = edge + ((size_t)((1 * 64 + u.pm) * 2 + fr)) * dff + f0; float* eu = edge + ((size_t)((2 * 64 + u.pm) * 2 + fr)) * dff + f0;
                    *(f32x4*)eg = acc[0][0][0][0]; *(f32x4*)(eg + 4) = acc[0][0][0][1]; *(f32x4*)eu = acc[0][1][0][0]; *(f32x4*)(eu + 4) = acc[0][1][0][1]; }
                else *(u32x4*)(ACT + (size_t)row * dff + f0) = w;
                if (ai == 1 && wr == 1 && m == 3 && fr >= 14) { float* el = edge + ((size_t)((0 * 64 + u.pm) * 2 + (fr - 14))) * dff + f0; *(f32x4*)el = acc[1][0][3][0]; *(f32x4*)(el + 4) = acc[1][0][3][1]; }
            }
        }
    }
};

template <class Epi, class Sched, bool ALIGN_EPI = false, bool SP2 = false>
__device__ __forceinline__ void gemm_phase(PG8_LAS unsigned char* lds, const Gemm g, const Sched& S, const Epi& E) {
    int tid_ = threadIdx.x; asm volatile("" : "+v"(tid_));
    const int tid = tid_, wid = __builtin_amdgcn_readfirstlane(tid >> 6), lane = tid & 63, wr = wid >> 2, wc = wid & 3, fr = lane & 15, fq = lane >> 4;
    const int K = g.K, nt = K / BK;
    unsigned voffA[2], voffB[2];
#pragma unroll
    for (int i = 0; i < 2; ++i) { int R, C; stage_rc(tid * 16 + i * 8192, R, C); const int Rb = Epi::PERM ? ((R & ~31) + perm32(R & 31)) : R;
        voffA[i] = (unsigned)(R * g.lda + C) * 2u; voffB[i] = (unsigned)(Rb * g.ldb + C) * 2u; }
    const size_t kstep = (size_t)(BK * 2);
    const size_t hsA = (size_t)HALF * g.lda * 2, hsB = (size_t)HALF * g.ldb * 2;
    const size_t tsA = 2 * hsA, tsB = 2 * hsB;
#define PG8_UA(u) ((const char*)g.A + (size_t)(u).pm * tsA + (g.agrp ? (size_t)((u).pn / g.agrp) * (size_t)K * 2 : (size_t)0))
#define PG8_UB(u) ((const char*)g.Bt + (size_t)(u).pn * tsB)
    const unsigned ldsw = (unsigned)wid * 1024u;
    const int aoff = lds_byte(wr * 64 + fr, fq * 8), boff = lds_byte(wc * 32 + fr, fq * 8);
#define PG8_SA(b, h) (((b) * 2 + (h)) * HTB)
#define PG8_SB(b, h) ((4 + (b) * 2 + (h)) * HTB)
#define PG8_STAGE(bufoff, gbase, voff) do { const char* _gb = (const char*)(gbase); asm volatile("" : "+s"(_gb));     \
        _Pragma("unroll") for (int _i = 0; _i < 2; ++_i) { unsigned _vo = (voff)[_i]; asm volatile("" : "+v"(_vo));     \
        __builtin_amdgcn_global_load_lds((const unsigned*)(_gb + _vo), (PG8_LAS unsigned*)(lds + (bufoff) + ldsw + _i * 8192), 16, 0, 0); } } while (0)
#define PG8_LDA(dst, b, h) do { _Pragma("unroll") for (int m = 0; m < 4; ++m) _Pragma("unroll") for (int k = 0; k < 2; ++k) dst[m][k] = *(const PG8_LAS bf16x8*)(lds + PG8_SA(b, h) + aoff + m * 2048 + k * 1024); } while (0)
#define PG8_LDB(dst, b, h) do { _Pragma("unroll") for (int n = 0; n < 2; ++n) _Pragma("unroll") for (int k = 0; k < 2; ++k) dst[n][k] = *(const PG8_LAS bf16x8*)(lds + PG8_SB(b, h) + boff + n * 2048 + k * 1024); } while (0)
#define PG8_MMA(ai, bj, At, Bt) do { __builtin_amdgcn_s_setprio(1); _Pragma("unroll") for (int m = 0; m < 4; ++m) _Pragma("unroll") for (int n = 0; n < 2; ++n) _Pragma("unroll") for (int k = 0; k < 2; ++k) \
        acc[ai][bj][m][n] = __builtin_amdgcn_mfma_f32_16x16x32_bf16(Bt[n][k], At[m][k], acc[ai][bj][m][n], 0, 0, 0); __builtin_amdgcn_s_setprio(0); } while (0)
#define PG8_WAIT_V(n) asm volatile("s_waitcnt vmcnt(" #n ")" ::: "memory")
#define PG8_WAIT_L(n) asm volatile("s_waitcnt lgkmcnt(" #n ")" ::: "memory")
#define PG8_BAR __builtin_amdgcn_s_barrier()
#define PG8_SCHED __builtin_amdgcn_sched_barrier(0)
    Unit cur, nxt; int ui = 0;
    if (!S.next(0, cur)) return;
    f32x4 acc[2][2][4][2];
#pragma unroll
    for (int a = 0; a < 2; ++a)
#pragma unroll
        for (int b = 0; b < 2; ++b)
#pragma unroll
            for (int m = 0; m < 4; ++m)
#pragma unroll
                for (int n = 0; n < 2; ++n) acc[a][b][m][n] = (f32x4){0.f, 0.f, 0.f, 0.f};
    bf16x8 At[4][2], B0[2][2], B1[2][2];
    const char* cA = PG8_UA(cur); const char* cB = PG8_UB(cur);
    S.a_ready(cur);
    if constexpr (SP2) {
        PG8_STAGE(PG8_SB(0, 0), cB, voffB); PG8_STAGE(PG8_SB(0, 1), cB + hsB, voffB); PG8_STAGE(PG8_SA(0, 0), cA, voffA); PG8_STAGE(PG8_SA(0, 1), cA + hsA, voffA);
        if (wr == 1) PG8_BAR;
        PG8_WAIT_V(2); PG8_BAR;
        PG8_STAGE(PG8_SB(1, 0), cB + kstep, voffB); PG8_STAGE(PG8_SA(1, 0), cA + kstep, voffA); PG8_STAGE(PG8_SB(1, 1), cB + hsB + kstep, voffB);
        PG8_WAIT_V(6); PG8_BAR;
    } else {
        PG8_STAGE(PG8_SB(0, 0), cB, voffB); PG8_STAGE(PG8_SA(0, 0), cA, voffA); PG8_STAGE(PG8_SB(0, 1), cB + hsB, voffB); PG8_STAGE(PG8_SA(0, 1), cA + hsA, voffA);
        if (wr == 1) PG8_BAR;
        PG8_WAIT_V(4); PG8_BAR;
        PG8_STAGE(PG8_SB(1, 0), cB + kstep, voffB); PG8_STAGE(PG8_SA(1, 0), cA + kstep, voffA); PG8_STAGE(PG8_SB(1, 1), cB + hsB + kstep, voffB);
        PG8_WAIT_V(6); PG8_BAR;
    }
    for (;;) {
        const bool has_next = S.next(ui + 1, nxt);
        const char* nA = has_next ? PG8_UA(nxt) : cA; const char* nB = has_next ? PG8_UB(nxt) : cB;
        for (int t = 0; t < nt; t += 2) {
            const bool last = (t == nt - 2);
            const char* a1 = cA + (size_t)(t + 1) * kstep;
            const char* a2 = last ? nA : cA + (size_t)(t + 2) * kstep; const char* b2 = last ? nB : cB + (size_t)(t + 2) * kstep;
            const char* a3 = a2 + kstep; const char* b3 = b2 + kstep;
            if (last && has_next) S.a_ready(nxt);
            if constexpr (SP2) {
            PG8_LDB(B0, 0, 0); PG8_LDB(B1, 0, 1); PG8_SCHED; PG8_LDA(At, 0, 0); PG8_STAGE(PG8_SA(1, 1), a1 + hsA, voffA);
            PG8_WAIT_V(8); PG8_WAIT_L(0); PG8_BAR; PG8_MMA(0, 0, At, B0); PG8_MMA(0, 1, At, B1); PG8_BAR; PG8_SCHED;
            PG8_LDA(At, 0, 1); PG8_STAGE(PG8_SB(0, 0), b2, voffB); PG8_STAGE(PG8_SB(0, 1), b2 + hsB, voffB); PG8_STAGE(PG8_SA(0, 0), a2, voffA);
            PG8_WAIT_V(8); PG8_WAIT_L(0); PG8_BAR; PG8_MMA(1, 0, At, B0); PG8_MMA(1, 1, At, B1); PG8_BAR; PG8_SCHED;
            PG8_LDB(B0, 1, 0); PG8_LDB(B1, 1, 1); PG8_SCHED; PG8_LDA(At, 1, 0); PG8_STAGE(PG8_SA(0, 1), a2 + hsA, voffA);
            PG8_WAIT_V(8); PG8_WAIT_L(0); PG8_BAR; PG8_MMA(0, 0, At, B0); PG8_MMA(0, 1, At, B1); PG8_BAR; PG8_SCHED;
            PG8_LDA(At, 1, 1); PG8_STAGE(PG8_SB(1, 0), b3, voffB); PG8_STAGE(PG8_SB(1, 1), b3 + hsB, voffB); PG8_STAGE(PG8_SA(1, 0), a3, voffA);
            PG8_WAIT_V(8); PG8_WAIT_L(0); PG8_BAR; PG8_MMA(1, 0, At, B0); PG8_MMA(1, 1, At, B1); PG8_BAR; PG8_SCHED;
            } else {
            PG8_LDB(B0, 0, 0); PG8_SCHED; PG8_LDA(At, 0, 0); PG8_STAGE(PG8_SA(1, 1), a1 + hsA, voffA);
            PG8_WAIT_L(8); PG8_BAR; PG8_WAIT_L(0); PG8_MMA(0, 0, At, B0); PG8_BAR; PG8_SCHED;
            PG8_LDB(B1, 0, 1); PG8_STAGE(PG8_SB(0, 0), b2, voffB);
            PG8_BAR; PG8_WAIT_L(0); PG8_MMA(0, 1, At, B1); PG8_BAR;
            PG8_LDA(At, 0, 1); PG8_STAGE(PG8_SA(0, 0), a2, voffA);
            PG8_BAR; PG8_WAIT_L(0); PG8_MMA(1, 0, At, B0); PG8_BAR; PG8_SCHED;
            PG8_STAGE(PG8_SB(0, 1), b2 + hsB, voffB);
            PG8_WAIT_V(6); PG8_BAR; PG8_MMA(1, 1, At, B1); PG8_BAR;
            PG8_LDB(B0, 1, 0); PG8_SCHED; PG8_LDA(At, 1, 0); PG8_STAGE(PG8_SA(0, 1), a2 + hsA, voffA);
            PG8_WAIT_L(8); PG8_BAR; PG8_WAIT_L(0); PG8_MMA(0, 0, At, B0); PG8_BAR; PG8_SCHED;
            PG8_LDB(B1, 1, 1); PG8_STAGE(PG8_SB(1, 0), b3, voffB);
            PG8_BAR; PG8_WAIT_L(0); PG8_MMA(0, 1, At, B1); PG8_BAR;
            PG8_LDA(At, 1, 1); PG8_STAGE(PG8_SA(1, 0), a3, voffA);
            PG8_BAR; PG8_WAIT_L(0); PG8_MMA(1, 0, At, B0); PG8_BAR; PG8_SCHED;
            PG8_STAGE(PG8_SB(1, 1), b3 + hsB, voffB);
            PG8_WAIT_V(6); PG8_BAR; PG8_MMA(1, 1, At, B1); PG8_BAR;
            }
        }
        if constexpr (ALIGN_EPI) { if (wr == 0) PG8_BAR; }
        if constexpr (!Epi::AFTER_DRAIN) { E(acc, cur, wr, wc, fr, fq); S.done(cur); }
        if (!has_next) break;
#pragma unroll
        for (int a = 0; a < 2; ++a)
#pragma unroll
            for (int b = 0; b < 2; ++b)
#pragma unroll
                for (int m = 0; m < 4; ++m)
#pragma unroll
                    for (int n = 0; n < 2; ++n) acc[a][b][m][n] = (f32x4){0.f, 0.f, 0.f, 0.f};
        cur = nxt; cA = nA; cB = nB; ++ui;
        if constexpr (ALIGN_EPI) { if (wr == 1) PG8_BAR; }
    }
    PG8_WAIT_V(0);
    if constexpr (!ALIGN_EPI) { if (wr == 0) PG8_BAR; }
    PG8_BAR;
    if constexpr (Epi::AFTER_DRAIN) { E.fused(acc, cur, wr, wc, fr, fq, lds, wid, lane); S.done(cur); }
#undef PG8_UA
#undef PG8_UB
#undef PG8_SA
#undef PG8_SB
#undef PG8_STAGE
#undef PG8_LDA
#undef PG8_LDB
#undef PG8_MMA
#undef PG8_WAIT_V
#undef PG8_WAIT_L
#undef PG8_BAR
#undef PG8_SCHED
}
}

typedef unsigned short bf16;
typedef short bf16x8 __attribute__((ext_vector_type(8)));
typedef float f32x4 __attribute__((ext_vector_type(4)));
typedef unsigned v4u __attribute__((ext_vector_type(4)));
typedef unsigned v2u __attribute__((ext_vector_type(2)));
typedef float f32x2_t __attribute__((ext_vector_type(2)));
#define LAS __attribute__((address_space(3)))
#define DI __device__ __forceinline__
constexpr int D = 2048, BATCH = 4, SEQ = 4096, DEPTH = 4, NH = 16, HD = 128, DFF = 5632;
constexpr int M = BATCH * SEQ;
constexpr int NPROJ = 14336;
constexpr int NPO = 12288;
constexpr int NIN = 14368;
constexpr int C_Q = 0, C_K = 2048, C_V = 4096, C_ZG = 6144, C_P = 8192, C_GB = 10240;
constexpr float EPS = 1e-6f;
constexpr int NWAVES = 8, NTHREADS = 512;

constexpr size_t MiB = 1u << 20;
constexpr size_t WS_CTL = 0;
constexpr size_t WS_WIN = 1 * MiB;
constexpr size_t WS_WOUT = 226 * MiB;
constexpr size_t WS_WUP = 258 * MiB;
constexpr size_t WS_WDN = 434 * MiB;
constexpr size_t WS_WPL = 522 * MiB;
constexpr size_t WS_H = 530 * MiB;
constexpr size_t WS_BA = 594 * MiB;
constexpr size_t WS_BETA = 596 * MiB;
constexpr size_t WS_G = 597 * MiB;
constexpr size_t WS_PROJ = 598 * MiB;
constexpr size_t WS_BIG2 = 1046 * MiB;
constexpr size_t WS_O = 1430 * MiB;
constexpr size_t WS_POOLED = WS_H;
constexpr size_t WS_YB = 1622 * MiB;
constexpr size_t WS_MIXED = WS_H;
constexpr size_t WS_EDGE = 1750 * MiB;
constexpr size_t WS_END = 1760 * MiB;
static_assert(WS_WIN + (size_t)4 * NIN * D * 2 <= WS_WOUT && WS_WUP + (size_t)4 * 2 * DFF * D * 2 <= WS_WDN && WS_WDN + (size_t)4 * D * DFF * 2 <= WS_WPL, "ws map");
static_assert(WS_PROJ + (size_t)M * NPROJ * 2 <= WS_BIG2 && WS_BIG2 + (size_t)3 * M * D * 4 <= WS_O, "ws map");

struct Ctx { const float* in[16]; float* out; unsigned char* ws; };
typedef LAS const unsigned long long* PTab;
DI unsigned long long tab_ld(PTab T, int i) { const unsigned long long v = T[i]; const unsigned lo = __builtin_amdgcn_readfirstlane((unsigned)v), hi = __builtin_amdgcn_readfirstlane((unsigned)(v >> 32)); return ((unsigned long long)hi << 32) | lo; }
#define GAS __attribute__((address_space(1)))
DI const float* inp(PTab T, int i) { return (const float*)(const GAS float*)tab_ld(T, i); }
DI float* outp(PTab T) { return (float*)(GAS float*)tab_ld(T, 16); }
DI unsigned char* wsp(PTab T) { return (unsigned char*)(GAS unsigned char*)tab_ld(T, 17); }
enum { I_X = 0, I_NMW, I_WIN, I_CQW, I_ALOG, I_DTB, I_GNW, I_PW, I_PS, I_WOUT, I_NFW, I_WUP, I_CFW, I_CFB, I_WDN, I_NFIN };

DI int otid() { int t = threadIdx.x; asm volatile("" : "+v"(t)); return t; }
DI float bf2f(bf16 b) { return __uint_as_float(((unsigned)b) << 16); }
DI unsigned f2bf(float f) { unsigned u = __float_as_uint(f); return (u + 0x7fffu + ((u >> 16) & 1u)) >> 16; }
DI unsigned pk2(float lo, float hi) { return f2bf(lo) | (f2bf(hi) << 16); }
DI float lo16(unsigned w) { return __uint_as_float(w << 16); }
DI float hi16(unsigned w) { return __uint_as_float(w & 0xffff0000u); }
DI float wave_sum(float v) {
#pragma unroll
    for (int o = 1; o < 64; o <<= 1) v += __shfl_xor(v, o);
    return v;
}
DI float sigmoidf_(float x) { return 1.0f / (1.0f + expf(-x)); }
DI float siluf_(float x) { return x / (1.0f + expf(-x)); }
DI float softplusf_(float x) { return fmaxf(x, 0.f) + log1pf(expf(-fabsf(x))); }
DI float fexp(float x) { return __builtin_amdgcn_exp2f(x * 1.4426950408889634f); }
DI float frcp(float x) { return __builtin_amdgcn_rcpf(x); }
DI float frsq(float x) { return __builtin_amdgcn_rsqf(x); }
DI float fsigmoid(float x) { return frcp(1.0f + fexp(-x)); }
DI float fsilu(float x) { return x * frcp(1.0f + fexp(-x)); }
DI float gelu_erf(float x) { return 0.5f * x * (1.0f + erff(x * 0.70710678118654752f)); }

constexpr int IT_IN = (D / 64) * (NIN / 32), IT_OUT = (D / 64) * (D / 32), IT_UP = (D / 64) * (2 * DFF / 32), IT_DN = (DFF / 64) * (D / 32), IT_PL = 4 * (512 / 64) * (512 / 32);
constexpr int IT_LAYER = IT_IN + IT_OUT + IT_UP + IT_DN + IT_PL;
struct CvItem { const float* src; bf16* dst; int ldw, K; };
DI CvItem cv_decode(PTab T, int it, int lane) {
    unsigned char* const ws = wsp(T);
    const int l = it / IT_LAYER; int r = it % IT_LAYER; CvItem c;
    const float* W; int ldw, sc, k0, K, n0; bf16* WT;
    if (r < IT_IN) { const int nblk = NIN / 32, kb = r / nblk, nb = r % nblk; n0 = 32 * nb; { const int pn = n0 >> 8, bj = (n0 >> 7) & 1, jj = n0 & 127;
            sc = pn < 24 ? n0 : pn < 40 ? (bj ? 10272 : 6144) + 128 * (pn - 24) + jj : pn < 48 ? 8224 + (n0 - 40 * 256) : pn < 56 ? 12320 + (n0 - 48 * 256) : 8192 + (n0 - NPROJ); }
        W = inp(T, I_WIN) + (size_t)l * D * NIN; ldw = NIN; k0 = 64 * kb; WT = (bf16*)(ws + WS_WIN) + (size_t)(l & 1) * NIN * D; K = D; }
    else if ((r -= IT_IN) < IT_PL) { const int g = r / 128, rr = r % 128, kb = rr / 16, nb = rr % 16; sc = 32 * nb; n0 = g * 512 + 32 * nb;
        W = inp(T, I_PW) + (size_t)(l * 4 + g) * 512 * 512; ldw = 512; k0 = 64 * kb; WT = (bf16*)(ws + WS_WPL) + (size_t)(l & 1) * D * 512; K = 512; }
    else if ((r -= IT_PL) < IT_OUT) { const int nblk = D / 32, kb = r / nblk, nb = r % nblk; n0 = 32 * nb; sc = n0; W = inp(T, I_WOUT) + (size_t)l * D * D; ldw = D; k0 = 64 * kb; WT = (bf16*)(ws + WS_WOUT) + (size_t)(l & 1) * D * D; K = D; }
    else if ((r -= IT_OUT) < IT_UP) { const int nblk = 2 * DFF / 32, kb = r / nblk, nb = r % nblk; n0 = 32 * nb; sc = ((n0 >> 7) & 1) * DFF + 128 * (n0 >> 8) + (n0 & 127);
        W = inp(T, I_WUP) + (size_t)l * D * 2 * DFF; ldw = 2 * DFF; k0 = 64 * kb; WT = (bf16*)(ws + WS_WUP) + (size_t)(l & 1) * 2 * DFF * D; K = D; }
    else { r -= IT_UP; const int nblk = D / 32, kb = r / nblk, nb = r % nblk; n0 = 32 * nb; sc = n0; W = inp(T, I_WDN) + (size_t)l * DFF * D; ldw = D; k0 = 64 * kb; WT = (bf16*)(ws + WS_WDN) + (size_t)(l & 1) * D * DFF; K = DFF; }
    c.src = W + (size_t)(k0 + (lane >> 3)) * ldw + sc + 4 * (lane & 7); c.dst = WT + (size_t)n0 * K + k0; c.ldw = ldw; c.K = K; return c;
}
DI void cv_load(const CvItem& c, float (&v)[32]) {
#pragma unroll
    for (int i = 0; i < 8; ++i) { const f32x4 t = *(const f32x4*)(c.src + (size_t)(8 * i) * c.ldw); v[4 * i] = t.x; v[4 * i + 1] = t.y; v[4 * i + 2] = t.z; v[4 * i + 3] = t.w; }
}
DI void cv_store(const CvItem& c, const float (&v)[32], LAS float* scr, int lane) {
#pragma unroll
    for (int i = 0; i < 8; ++i)
#pragma unroll
        for (int e = 0; e < 4; ++e) scr[(8 * i + (lane >> 3)) * 33 + 4 * (lane & 7) + e] = v[4 * i + e];
    asm volatile("s_waitcnt lgkmcnt(0)" ::: "memory");
    const int cc = lane & 7;
#pragma unroll
    for (int j = 0; j < 4; ++j) { const int n = (lane >> 3) + 8 * j; const LAS float* s = scr + (8 * cc) * 33 + n;
        v4u o; o.x = pk2(s[0 * 33], s[1 * 33]); o.y = pk2(s[2 * 33], s[3 * 33]); o.z = pk2(s[4 * 33], s[5 * 33]); o.w = pk2(s[6 * 33], s[7 * 33]);
        *(v4u*)(c.dst + (size_t)n * c.K + 8 * cc) = o; }
    asm volatile("s_waitcnt lgkmcnt(0)" ::: "memory");
}
constexpr int IT_FIRST = IT_IN + IT_PL;
DI void ph_convert(PTab T, LAS unsigned char* lds, int base, int end, int wg0) {
    const int tid = otid(), lane = tid & 63, wave = __builtin_amdgcn_readfirstlane(tid >> 6), gw = ((int)blockIdx.x - wg0) * NWAVES + wave, ngw = ((int)gridDim.x - wg0) * NWAVES;
    LAS float* scr = (LAS float*)(lds + wave * 16384);
    float va[32], vb[32];
    int it = base + gw; if (gw < 0 || it >= end) return;
    CvItem ca = cv_decode(T, it, lane); cv_load(ca, va);
    for (;;) {
        const int itb = it + ngw; const bool hb = itb < end; CvItem cb = ca;
        if (hb) { cb = cv_decode(T, itb, lane); cv_load(cb, vb); }
        cv_store(ca, va, scr, lane);
        if (!hb) break;
        const int itc = itb + ngw; const bool hc = itc < end;
        if (hc) { ca = cv_decode(T, itc, lane); cv_load(ca, va); }
        cv_store(cb, vb, scr, lane);
        if (!hc) break;
        it = itc;
    }
}

DI void ph_rmsnorm_bf16(const float* x, const float* w, bf16* out) {
    const int tid = otid(), lane = tid & 63, wave = __builtin_amdgcn_readfirstlane(tid >> 6), gw = blockIdx.x * NWAVES + wave, ngw = gridDim.x * NWAVES;
    for (int m = gw; m < M; m += ngw) {
        const f32x4* xr = (const f32x4*)(x + (size_t)m * D) + 2 * lane; f32x4 v[8]; float s = 0.f;
#pragma unroll
        for (int j = 0; j < 8; ++j) { v[j] = xr[128 * (j >> 1) + (j & 1)]; s += (v[j].x * v[j].x + v[j].y * v[j].y) + (v[j].z * v[j].z + v[j].w * v[j].w); }
        const float rstd = 1.0f / sqrtf(wave_sum(s) * (1.0f / D) + EPS);
        v4u* o = (v4u*)(out + (size_t)m * D) + lane;
#pragma unroll
        for (int jj = 0; jj < 4; ++jj) { const f32x4 w0 = ((const f32x4*)w)[2 * lane + 128 * jj], w1 = ((const f32x4*)w)[2 * lane + 128 * jj + 1]; const f32x4 a = v[2 * jj], b = v[2 * jj + 1]; v4u p;
            p.x = pk2(a.x * rstd * w0.x, a.y * rstd * w0.y); p.y = pk2(a.z * rstd * w0.z, a.w * rstd * w0.w); p.z = pk2(b.x * rstd * w1.x, b.y * rstd * w1.y); p.w = pk2(b.z * rstd * w1.z, b.w * rstd * w1.w); o[64 * jj] = p; }
    }
}
DI void ph_rmsnorm_f32(const float* x, const float* w, float* out) {
    const int tid = otid(), lane = tid & 63, wave = __builtin_amdgcn_readfirstlane(tid >> 6), gw = blockIdx.x * NWAVES + wave, ngw = gridDim.x * NWAVES;
    for (int m = gw; m < M; m += ngw) {
        const f32x4* xr = (const f32x4*)(x + (size_t)m * D) + lane; f32x4 v[8]; float s = 0.f;
#pragma unroll
        for (int j = 0; j < 8; ++j) { v[j] = xr[64 * j]; s += (v[j].x * v[j].x + v[j].y * v[j].y) + (v[j].z * v[j].z + v[j].w * v[j].w); }
        const float rstd = 1.0f / sqrtf(wave_sum(s) * (1.0f / D) + EPS);
        f32x4* o = (f32x4*)(out + (size_t)m * D) + lane;
#pragma unroll
        for (int j = 0; j < 8; ++j) { const f32x4 ww = ((const f32x4*)w)[lane + 64 * j]; o[64 * j] = (f32x4){v[j].x * rstd * ww.x, v[j].y * rstd * ww.y, v[j].z * rstd * ww.z, v[j].w * rstd * ww.w}; }
    }
}

DI void ph_ba(PTab T, int l, LAS unsigned char* lds) {
    const int tid = otid(), lane = tid & 63, wave = __builtin_amdgcn_readfirstlane(tid >> 6);
    unsigned char* const ws = wsp(T);
    const bf16* H = (const bf16*)(ws + WS_H); const bf16* Wt = (const bf16*)(ws + WS_WIN) + ((size_t)(l & 1) * NIN + NPROJ) * D; float* BA = (float*)(ws + WS_BA);
    const int r = lane & 15, g = lane >> 4, w4 = wave & 3, kh = wave >> 2;
    LAS f32x4* xch = (LAS f32x4*)lds + (w4 * 64 + lane) * 2;
    for (int wt = blockIdx.x * 4 + w4; wt < M / 16; wt += gridDim.x * 4) {
        const bf16* ap = H + (size_t)(wt * 16 + r) * D + 8 * g + kh * (D / 2); const bf16* b0p = Wt + (size_t)r * D + 8 * g + kh * (D / 2); const bf16* b1p = Wt + (size_t)(16 + r) * D + 8 * g + kh * (D / 2);
        f32x4 acc0 = {0.f, 0.f, 0.f, 0.f}, acc1 = {0.f, 0.f, 0.f, 0.f};
        bf16x8 xa[8], xb[8], xc[8], ya[8], yb[8], yc[8];
#define BA_LD(A_, B_, C_, k1) do { _Pragma("unroll") for (int i = 0; i < 8; ++i) { A_[i] = *(const bf16x8*)(ap + (k1) + 32 * i); B_[i] = *(const bf16x8*)(b0p + (k1) + 32 * i); C_[i] = *(const bf16x8*)(b1p + (k1) + 32 * i); } } while (0)
#define BA_MM(A_, B_, C_) do { _Pragma("unroll") for (int i = 0; i < 8; ++i) { acc0 = __builtin_amdgcn_mfma_f32_16x16x32_bf16(A_[i], B_[i], acc0, 0, 0, 0); acc1 = __builtin_amdgcn_mfma_f32_16x16x32_bf16(A_[i], C_[i], acc1, 0, 0, 0); } } while (0)
        BA_LD(xa, xb, xc, 0); BA_LD(ya, yb, yc, 256);
        BA_MM(xa, xb, xc); __builtin_amdgcn_sched_barrier(0); BA_LD(xa, xb, xc, 512); __builtin_amdgcn_sched_barrier(0);
        BA_MM(ya, yb, yc); __builtin_amdgcn_sched_barrier(0); BA_LD(ya, yb, yc, 768); __builtin_amdgcn_sched_barrier(0);
        BA_MM(xa, xb, xc); BA_MM(ya, yb, yc);
#undef BA_LD
#undef BA_MM
        if (kh) { xch[0] = acc0; xch[1] = acc1; }
        __syncthreads();
        if (!kh) { acc0 += xch[0]; acc1 += xch[1];
#pragma unroll
            for (int j = 0; j < 4; ++j) { float* o = BA + (size_t)(wt * 16 + 4 * g + j) * 32; o[r] = acc0[j]; o[16 + r] = acc1[j]; } }
        __syncthreads();
    }
}

template <int WIN> DI void pooled_run(const bf16* P, bf16* PO, int m0, int col) {
    constexpr int B = 8;
    float s[8]; const int t0 = m0 & (SEQ - 1);
#pragma unroll
    for (int e = 0; e < 8; ++e) s[e] = 0.f;
    { v4u w[WIN];
#pragma unroll
      for (int j = 0; j < WIN; ++j) w[j] = (t0 - WIN + j >= 0) ? *(const v4u*)(P + (size_t)(m0 - WIN + j) * NPO + col) : (v4u){0u, 0u, 0u, 0u};
#pragma unroll
      for (int j = 0; j < WIN; ++j)
#pragma unroll
          for (int e = 0; e < 4; ++e) { s[2 * e] += lo16(w[j][e]); s[2 * e + 1] += hi16(w[j][e]); } }
    for (int base = 0; base < 32; base += B) {
        v4u xn[B], xo[B];
#pragma unroll
        for (int j = 0; j < B; ++j) xn[j] = *(const v4u*)(P + (size_t)(m0 + base + j) * NPO + col);
#pragma unroll
        for (int j = 0; j < B; ++j) xo[j] = (t0 + base + j - WIN >= 0) ? *(const v4u*)(P + (size_t)(m0 + base + j - WIN) * NPO + col) : (v4u){0u, 0u, 0u, 0u};
#pragma unroll
        for (int j = 0; j < B; ++j) { const int t = t0 + base + j; const float inv = frcp((float)((t + 1) < WIN ? (t + 1) : WIN)); v4u o;
#pragma unroll
            for (int e = 0; e < 4; ++e) { const float x0 = lo16(xn[j][e]), x1 = hi16(xn[j][e]); s[2 * e] += x0 - lo16(xo[j][e]); s[2 * e + 1] += x1 - hi16(xo[j][e]); o[e] = pk2(s[2 * e] * inv - x0, s[2 * e + 1] * inv - x1); }
            *(v4u*)(PO + (size_t)(m0 + base + j) * D + col) = o; }
    }
}
DI void ph_pooled(PTab T) {
    unsigned char* const ws = wsp(T); const bf16* P = (const bf16*)(ws + WS_PROJ) + C_P; bf16* PO = (bf16*)(ws + WS_POOLED);
    const int tid = otid();
    for (int e = blockIdx.x * NTHREADS + tid; e < (M / 32) * (D / 8); e += gridDim.x * NTHREADS) {
        const int c8 = e & 255, rb = e >> 8, col = 8 * c8, gi = c8 >> 6, m0 = rb * 32;
        if (gi == 0) pooled_run<2>(P, PO, m0, col); else if (gi == 1) pooled_run<4>(P, PO, m0, col); else if (gi == 2) pooled_run<8>(P, PO, m0, col); else pooled_run<16>(P, PO, m0, col);
    }
}
DI void ph_mix(PTab T, int l) {
    const int tid = otid(); unsigned char* const ws = wsp(T);
    const bf16* P = (const bf16*)(ws + WS_PROJ); const bf16* Y = (const bf16*)(ws + WS_O); const float* SSO = (const float*)(ws + WS_G); const bf16* YB = (const bf16*)(ws + WS_YB); bf16* MX = (bf16*)(ws + WS_MIXED);
    const float* gnw = inp(T, I_GNW) + l * HD;
    for (int e = blockIdx.x * NTHREADS + tid; e < M * (D / 8); e += gridDim.x * NTHREADS) {
        const int m = e >> 8, cb = e & 255, col = 8 * cb, hh = cb >> 4;
        const v4u o = *(const v4u*)(Y + (size_t)m * D + col), zg = *(const v4u*)(P + (size_t)m * NPO + C_ZG + col), yb = *(const v4u*)(YB + (size_t)m * D + col);
        const float rstd = frsq(SSO[(size_t)m * 16 + hh] * (1.0f / HD) + EPS);
        const f32x4 g0 = *(const f32x4*)(gnw + (col & 127)) * rstd, g1 = *(const f32x4*)(gnw + (col & 127) + 4) * rstd;
        v4u r;
#pragma unroll
        for (int i = 0; i < 4; ++i) { const float gl = (i < 2) ? g0[2 * i] : g1[2 * i - 4], gh = (i < 2) ? g0[2 * i + 1] : g1[2 * i - 3];
            r[i] = pk2(lo16(zg[i]) * (lo16(o[i]) * gl) + lo16(yb[i]), hi16(zg[i]) * (hi16(o[i]) * gh) + hi16(yb[i])); }
        *(v4u*)(MX + (size_t)m * D + col) = r;
    }
}
DI void ph_glu_fix(PTab T, int l) {
    unsigned char* const ws = wsp(T); const float* edge = (const float*)(ws + WS_EDGE); bf16* ACT = (bf16*)(ws + WS_BIG2);
    const float* cw = inp(T, I_CFW) + (size_t)l * 3 * DFF; const float* cb = inp(T, I_CFB) + (size_t)l * DFF;
    const int tid = otid();
    for (int e = blockIdx.x * NTHREADS + tid; e < 64 * DFF; e += gridDim.x * NTHREADS) {
        const int pm = e / DFF, f = e % DFF; if ((pm & 15) == 0) continue;
        const float gm2 = edge[((size_t)((0 * 64 + pm - 1) * 2 + 0)) * DFF + f], gm1 = edge[((size_t)((0 * 64 + pm - 1) * 2 + 1)) * DFF + f];
        const float g0 = edge[((size_t)((1 * 64 + pm) * 2 + 0)) * DFF + f], g1 = edge[((size_t)((1 * 64 + pm) * 2 + 1)) * DFF + f];
        const float u0 = edge[((size_t)((2 * 64 + pm) * 2 + 0)) * DFF + f], u1 = edge[((size_t)((2 * 64 + pm) * 2 + 1)) * DFF + f];
        const float w0 = cw[f], w1 = cw[DFF + f], w2 = cw[2 * DFF + f], bb = cb[f];
        ACT[(size_t)(pm * 256) * DFF + f] = (bf16)f2bf(gelu_erf(w0 * gm2 + w1 * gm1 + w2 * g0 + bb) * u0);
        ACT[(size_t)(pm * 256 + 1) * DFF + f] = (bf16)f2bf(gelu_erf(w0 * gm1 + w1 * g0 + w2 * g1 + bb) * u1);
    }
}
typedef float f32x16 __attribute__((ext_vector_type(16)));
typedef __bf16 bf16x2_t __attribute__((ext_vector_type(2)));
DI unsigned cvtpk(float lo, float hi) { const f32x2_t v = {lo, hi}; const bf16x2_t b = __builtin_convertvector(v, bf16x2_t); return __builtin_bit_cast(unsigned, b); }
DI bf16x8 mk8(float a0, float a1, float a2, float a3, float a4, float a5, float a6, float a7) { v4u p; p.x = cvtpk(a0, a1); p.y = cvtpk(a2, a3); p.z = cvtpk(a4, a5); p.w = cvtpk(a6, a7); return __builtin_bit_cast(bf16x8, p); }
#define MFMA32(a, b, c) __builtin_amdgcn_mfma_f32_32x32x16_bf16((a), (b), (c), 0, 0, 0)
#define PACK_STEP(x, s) mk8((x)[8 * (s)], (x)[8 * (s) + 1], (x)[8 * (s) + 2], (x)[8 * (s) + 3], (x)[8 * (s) + 4], (x)[8 * (s) + 5], (x)[8 * (s) + 6], (x)[8 * (s) + 7])
DI f32x16 zero16() { f32x16 z; for (int i = 0; i < 16; ++i) z[i] = 0.f; return z; }
DI bf16x8 frag_row(const LAS float* p) { const f32x4 a = *(const LAS f32x4*)p, b = *(const LAS f32x4*)(p + 4); return mk8(a.x, a.y, a.z, a.w, b.x, b.y, b.z, b.w); }
DI bf16x8 frag_row_s(const LAS float* p, const LAS float* f) { const f32x4 a = *(const LAS f32x4*)p, b = *(const LAS f32x4*)(p + 4), fa = *(const LAS f32x4*)f, fb = *(const LAS f32x4*)(f + 4);
    return mk8(a.x * fa.x, a.y * fa.y, a.z * fa.z, a.w * fa.w, b.x * fb.x, b.y * fb.y, b.z * fb.z, b.w * fb.w); }
DI bf16x8 frag_col(const LAS float* p, int stride) { return mk8(p[0], p[stride], p[2 * stride], p[3 * stride], p[4 * stride], p[5 * stride], p[6 * stride], p[7 * stride]); }

constexpr int OFF_WT = 0, OFF_QDT = 16384, OFF_KE = 32768, OFF_ATT = 49152, OFF_U = 55296, MAIN_BYTES = 49152, ATT_BYTES = 6144, UNIT_BYTES = 71680;
constexpr int NUNITS = BATCH * NH * (SEQ / 64);
static_assert((size_t)NUNITS * UNIT_BYTES <= 384 * MiB, "gdn image fits its region");
constexpr int QS = 132, LS = 68;
constexpr int L_QN = 0, L_KN = 64 * QS * 4, L_VN = 2 * 64 * QS * 4, L_LM = 3 * 64 * QS * 4, L_TM = L_LM + 64 * LS * 4, L_VEC = L_TM + 64 * LS * 4;
static_assert(L_VEC + 5 * 256 <= 161792, "chunk-local LDS map");

#define LDS_BAR() do { asm volatile("s_waitcnt lgkmcnt(0)" ::: "memory"); __builtin_amdgcn_s_barrier(); asm volatile("" ::: "memory"); } while (0)
struct ChunkIn { v4u raw[3][5]; float b_raw, a_raw; };
DI void gdn_chunk_load(PTab T, int unit, ChunkIn& in, int lane, int w) {
    unsigned char* const ws = wsp(T);
    const int bh = unit >> 6, n = unit & 63, b = bh >> 4, hh = bh & 15, m0 = b * SEQ + n * 64, q4 = lane >> 4;
    const bf16* P = (const bf16*)(ws + WS_PROJ) + (size_t)hh * HD + 8 * (lane & 15);
#pragma unroll
    for (int sec = 0; sec < 3; ++sec)
#pragma unroll
        for (int i = 0; i < 5; ++i) { const int rr = 8 * w + 2 * q4 - 3 + i; in.raw[sec][i] = (n * 64 + rr >= 0) ? *(const v4u*)(P + (size_t)(m0 + rr) * NPO + sec * D) : (v4u){0u, 0u, 0u, 0u}; }
    if (w == 0) { const float* ba = (const float*)(ws + WS_BA) + (size_t)(m0 + lane) * 32; in.b_raw = ba[hh]; in.a_raw = ba[16 + hh]; } else { in.b_raw = 0.f; in.a_raw = 0.f; }
}
DI void gdn_chunk_unit(PTab T, int l, LAS unsigned char* lds, int unit, int next_unit, ChunkIn& in) {
    const int tid = otid(), lane = tid & 63, w = __builtin_amdgcn_readfirstlane(tid >> 6), c = lane & 31, h = lane >> 5;
    unsigned char* const ws = wsp(T);
    const int bh = unit >> 6, hh = bh & 15;
    LAS float* QN = (LAS float*)(lds + L_QN); LAS float* KN = (LAS float*)(lds + L_KN); LAS float* VN = (LAS float*)(lds + L_VN);
    LAS float* LM = (LAS float*)(lds + L_LM); LAS float* TM = (LAS float*)(lds + L_TM);
    LAS float* VG = (LAS float*)(lds + L_VEC); LAS float* VBETA = VG + 64; LAS float* VEG = VG + 128; LAS float* VEKE = VG + 192; LAS float* VBEG = VG + 256;
    unsigned char* const ub = ws + WS_BIG2 + (size_t)unit * UNIT_BYTES;
    {
        const int q4 = lane >> 4, c8 = 8 * (lane & 15);
        const float* cw = inp(T, I_CQW) + (size_t)l * 4 * 3 * D + hh * HD + c8;
#pragma unroll
        for (int sec = 0; sec < 3; ++sec) {
            f32x4 wa[4], wb[4];
#pragma unroll
            for (int j = 0; j < 4; ++j) { wa[j] = *(const f32x4*)(cw + (size_t)j * 3 * D + sec * D); wb[j] = *(const f32x4*)(cw + (size_t)j * 3 * D + sec * D + 4); }
            LAS float* dst = (sec == 0 ? QN : sec == 1 ? KN : VN) + c8;
            float a[2][8];
#pragma unroll
            for (int r = 0; r < 2; ++r) { float x[8];
#pragma unroll
                for (int e = 0; e < 8; ++e) x[e] = 0.f;
#pragma unroll
                for (int j = 0; j < 4; ++j) { const v4u rw = in.raw[sec][r + j];
#pragma unroll
                    for (int e = 0; e < 4; ++e) { const float wl = (e < 2) ? wa[j][2 * e] : wb[j][2 * e - 4], wh = (e < 2) ? wa[j][2 * e + 1] : wb[j][2 * e - 3]; x[2 * e] += wl * lo16(rw[e]); x[2 * e + 1] += wh * hi16(rw[e]); } }
#pragma unroll
                for (int e = 0; e < 8; ++e) a[r][e] = fsilu(x[e]); }
            if (sec < 2) {
                float ss[2];
#pragma unroll
                for (int r = 0; r < 2; ++r) { ss[r] = 0.f;
#pragma unroll
                    for (int e = 0; e < 8; ++e) ss[r] += a[r][e] * a[r][e]; }
#pragma unroll
                for (int o = 1; o < 16; o <<= 1)
#pragma unroll
                    for (int r = 0; r < 2; ++r) ss[r] += __shfl_xor(ss[r], o);
#pragma unroll
                for (int r = 0; r < 2; ++r) { float sc = frsq(ss[r] + EPS); if (sec == 0) sc *= 0.08838834764831845f;
#pragma unroll
                    for (int e = 0; e < 8; ++e) a[r][e] *= sc; }
            }
#pragma unroll
            for (int r = 0; r < 2; ++r) { LAS float* d = dst + (8 * w + 2 * q4 + r) * QS; *(LAS f32x4*)d = (f32x4){a[r][0], a[r][1], a[r][2], a[r][3]}; *(LAS f32x4*)(d + 4) = (f32x4){a[r][4], a[r][5], a[r][6], a[r][7]}; }
        }
        if (w == 0) {
            const float beta = fsigmoid(in.b_raw); const float sx = in.a_raw + inp(T, I_DTB)[l * NH + hh], se = fexp(-fabsf(sx));
            const float sp = fmaxf(sx, 0.f) + (se < 1e-3f ? se * (1.0f - 0.5f * se) : __builtin_amdgcn_logf(1.0f + se) * 0.6931471805599453f);
            const float g = -fexp(inp(T, I_ALOG)[l * NH + hh]) * sp;
            float G = g;
#pragma unroll
            for (int o = 1; o < 64; o <<= 1) { const float t = __shfl_up(G, o); if (lane >= o) G += t; }
            const float G63 = __shfl(G, 63); const float eg = fexp(G);
            VG[lane] = G; VBETA[lane] = beta; VEG[lane] = eg; VEKE[lane] = fexp(G63 - G); VBEG[lane] = beta * eg;
            if (lane == 63) ((float*)(ws + WS_BETA))[unit] = eg;
        }
        if (next_unit >= 0) gdn_chunk_load(T, next_unit, in, lane, w);
    }
    LDS_BAR();
    if (w < 3) {
        const int ti = (w == 0) ? 0 : 1, tj = (w == 2) ? 1 : 0;
        f32x16 acc = zero16();
#pragma unroll
        for (int ks = 0; ks < 8; ++ks) acc = MFMA32(frag_row(KN + (32 * ti + c) * QS + 16 * ks + 8 * h), frag_row(KN + (32 * tj + c) * QS + 16 * ks + 8 * h), acc);
        const int jp = 32 * tj + c; const float Gj = VG[jp];
#pragma unroll
        for (int g4 = 0; g4 < 4; ++g4) { const int ip0 = 32 * ti + 8 * g4 + 4 * h; const f32x4 Gi = *(const LAS f32x4*)(VG + ip0), Bi = *(const LAS f32x4*)(VBETA + ip0);
#pragma unroll
            for (int q = 0; q < 4; ++q) { const int ip = ip0 + q; LM[ip * LS + jp] = (ip > jp) ? Bi[q] * acc[4 * g4 + q] * fexp(Gi[q] - Gj) : 0.f; } }
    }
    LDS_BAR();
    if (w == 0) {
        { const int blk = lane >> 4, cc = lane & 15; const LAS float* Lp = LM + (16 * blk) * LS + 16 * blk; float t[16];
#pragma unroll
          for (int ii = 0; ii < 16; ++ii) {
              float a = (cc == ii) ? 1.f : 0.f;
#pragma unroll
              for (int j4 = 0; j4 < (ii + 3) / 4; ++j4) { const f32x4 lv = *(const LAS f32x4*)(Lp + ii * LS + 4 * j4);
#pragma unroll
                  for (int q = 0; q < 4; ++q) if (4 * j4 + q < ii) a -= lv[q] * t[4 * j4 + q]; }
              t[ii] = a;
          }
#pragma unroll
          for (int ii = 0; ii < 16; ++ii) TM[(16 * blk + ii) * LS + 16 * blk + cc] = t[ii];
          if (!(blk & 1)) {
#pragma unroll
              for (int ii = 0; ii < 16; ++ii) TM[(16 * blk + ii) * LS + 16 * blk + 16 + cc] = 0.f; }
        }
        asm volatile("s_waitcnt lgkmcnt(0)" ::: "memory");
        { const int p = c >> 4, r15 = c & 15, ro = p ? 48 : 16, co = p ? 32 : 0;
          const f32x16 x1 = MFMA32(frag_row(LM + (ro + r15) * LS + co + 8 * h), frag_col(TM + (co + 8 * h) * LS + co + r15, LS), zero16());
          const LAS float* tp = TM + (ro + r15) * LS + ro + 4 * h; const f32x4 a = *(const LAS f32x4*)tp, bq = *(const LAS f32x4*)(tp + 8);
          const bf16x8 xb0 = PACK_STEP(x1, 0), xb1 = PACK_STEP(x1, 1);
          const f32x16 y1 = MFMA32(mk8(a.x, a.y, a.z, a.w, bq.x, bq.y, bq.z, bq.w), p ? xb1 : xb0, zero16());
#pragma unroll
          for (int g4 = 0; g4 < 2; ++g4)
#pragma unroll
              for (int q = 0; q < 4; ++q) { const int rr = 8 * g4 + 4 * h + q; TM[(ro + rr) * LS + co + r15] = -(p ? y1[8 + 4 * g4 + q] : y1[4 * g4 + q]); }
        }
        asm volatile("s_waitcnt lgkmcnt(0)" ::: "memory");
        f32x16 x = zero16();
#pragma unroll
        for (int ks = 0; ks < 2; ++ks) x = MFMA32(frag_row(LM + (32 + c) * LS + 16 * ks + 8 * h), frag_col(TM + (16 * ks + 8 * h) * LS + c, LS), x);
        f32x16 y = zero16();
#pragma unroll
        for (int s = 0; s < 2; ++s) { const LAS float* tp = TM + (32 + c) * LS + 32 + 16 * s + 4 * h; const f32x4 a = *(const LAS f32x4*)tp, bq = *(const LAS f32x4*)(tp + 8);
            y = MFMA32(mk8(a.x, a.y, a.z, a.w, bq.x, bq.y, bq.z, bq.w), PACK_STEP(x, s), y); }
#pragma unroll
        for (int g4 = 0; g4 < 4; ++g4)
#pragma unroll
            for (int q = 0; q < 4; ++q) TM[(32 + 8 * g4 + 4 * h + q) * LS + c] = -y[4 * g4 + q];
    } else if (w < 4) {
        const int tj = (w == 3) ? 1 : 0, ti = (w == 1) ? 0 : 1, t3 = w - 1;
        f32x16 acc = zero16();
#pragma unroll
        for (int ks = 0; ks < 8; ++ks) acc = MFMA32(frag_row(KN + (32 * tj + c) * QS + 16 * ks + 8 * h), frag_row(QN + (32 * ti + c) * QS + 16 * ks + 8 * h), acc);
        const int ip = 32 * ti + c; const float Gi = VG[ip];
#pragma unroll
        for (int g4 = 0; g4 < 4; ++g4) { const int jp0 = 32 * tj + 8 * g4 + 4 * h; const f32x4 Gj = *(const LAS f32x4*)(VG + jp0);
#pragma unroll
            for (int q = 0; q < 4; ++q) acc[4 * g4 + q] = (ip >= jp0 + q) ? acc[4 * g4 + q] * fexp(Gi - Gj[q]) : 0.f; }
        *(bf16x8*)(ub + OFF_ATT + (t3 * 2 + 0) * 1024 + lane * 16) = PACK_STEP(acc, 0);
        *(bf16x8*)(ub + OFF_ATT + (t3 * 2 + 1) * 1024 + lane * 16) = PACK_STEP(acc, 1);
    } else if (w < 6) {
        const int ti = w - 4; const float e = VEG[32 * ti + c];
#pragma unroll
        for (int d = 0; d < 4; ++d)
#pragma unroll
            for (int s = 0; s < 2; ++s) { const LAS float* p = QN + (32 * ti + c) * QS + 32 * d + 16 * s + 4 * h; const f32x4 a = *(const LAS f32x4*)p, bq = *(const LAS f32x4*)(p + 8);
                *(bf16x8*)(ub + OFF_QDT + ((d * 2 + ti) * 2 + s) * 1024 + lane * 16) = mk8(a.x * e, a.y * e, a.z * e, a.w * e, bq.x * e, bq.y * e, bq.z * e, bq.w * e); }
    } else {
        const int tj = w - 6;
#pragma unroll
        for (int s = 0; s < 2; ++s) { const int tok0 = 32 * tj + 16 * s + 4 * h; const f32x4 fa = *(const LAS f32x4*)(VEKE + tok0), fb = *(const LAS f32x4*)(VEKE + tok0 + 8);
#pragma unroll
            for (int d = 0; d < 4; ++d) { const LAS float* p = KN + tok0 * QS + 32 * d + c;
                *(bf16x8*)(ub + OFF_KE + ((d * 2 + tj) * 2 + s) * 1024 + lane * 16) = mk8(p[0] * fa.x, p[QS] * fa.y, p[2 * QS] * fa.z, p[3 * QS] * fa.w, p[8 * QS] * fb.x, p[9 * QS] * fb.y, p[10 * QS] * fb.z, p[11 * QS] * fb.w); } }
    }
    LDS_BAR();
    {
        const int d = w >> 1, ti = w & 1; f32x16 acc = zero16();
#pragma unroll
        for (int ks = 0; ks < 4; ++ks) if (ks < 2 || ti == 1)
            acc = MFMA32(frag_col(KN + (16 * ks + 8 * h) * QS + 32 * d + c, QS), frag_row_s(TM + (32 * ti + c) * LS + 16 * ks + 8 * h, VBEG + 16 * ks + 8 * h), acc);
#pragma unroll
        for (int i = 0; i < 16; ++i) acc[i] = -acc[i];
        *(bf16x8*)(ub + OFF_WT + ((d * 2 + ti) * 2 + 0) * 1024 + lane * 16) = PACK_STEP(acc, 0);
        *(bf16x8*)(ub + OFF_WT + ((d * 2 + ti) * 2 + 1) * 1024 + lane * 16) = PACK_STEP(acc, 1);
    }
    {
        const int vt = w >> 1, ti = 1 - (w & 1); f32x16 acc = zero16();
#pragma unroll
        for (int ks = 0; ks < 4; ++ks) if (ks < 2 || ti == 1)
            acc = MFMA32(frag_row_s(TM + (32 * ti + c) * LS + 16 * ks + 8 * h, VBETA + 16 * ks + 8 * h), frag_col(VN + (16 * ks + 8 * h) * QS + 32 * vt + c, QS), acc);
        *(bf16x8*)(ub + OFF_U + ((ti * 4 + vt) * 2 + 0) * 1024 + lane * 16) = PACK_STEP(acc, 0);
        *(bf16x8*)(ub + OFF_U + ((ti * 4 + vt) * 2 + 1) * 1024 + lane * 16) = PACK_STEP(acc, 1);
    }
    LDS_BAR();
}
DI void ph_gdn_chunks(PTab T, int l, LAS unsigned char* lds) {
    const int per = NUNITS / gridDim.x, u0 = blockIdx.x * per, u1 = (blockIdx.x == gridDim.x - 1) ? NUNITS : u0 + per;
    const int tid = otid(), lane = tid & 63, w = __builtin_amdgcn_readfirstlane(tid >> 6);
    ChunkIn in; if (u0 < u1) gdn_chunk_load(T, u0, in, lane, w);
    for (int unit = u0; unit < u1; ++unit) gdn_chunk_unit(T, l, lds, unit, unit + 1 < u1 ? unit + 1 : -1, in);
}

constexpr int A_BYTES = 49152, B_BYTES = 22528, SC_A = 0, SC_B = 2 * A_BYTES, SC_OST = SC_B + 2 * B_BYTES, OST_STRIDE = 272, SC_SSX = SC_OST + 64 * OST_STRIDE, SC_END = SC_SSX + 2048;
#define SCAN_BAR() do { asm volatile("" ::: "memory"); __builtin_amdgcn_s_barrier(); asm volatile("" ::: "memory"); } while (0)
DI f32x16 unpack16(const bf16x8 a, const bf16x8 b) {
    const v4u ua = __builtin_bit_cast(v4u, a), ub = __builtin_bit_cast(v4u, b); f32x16 r;
#pragma unroll
    for (int i = 0; i < 4; ++i) { r[2 * i] = lo16(ua[i]); r[2 * i + 1] = hi16(ua[i]); r[8 + 2 * i] = lo16(ub[i]); r[8 + 2 * i + 1] = hi16(ub[i]); }
    return r;
}
DI void ph_gdn_scan(PTab T, LAS unsigned char* lds, int bh) {
    const int tid = otid(), lane = tid & 63, w = __builtin_amdgcn_readfirstlane(tid >> 6), c = lane & 31, h = lane >> 5;
    unsigned char* const ws = wsp(T);
    const unsigned char* const gb = ws + WS_BIG2 + (size_t)bh * 64 * UNIT_BYTES;
    const int b = bh >> 4, hh = bh & 15;
    if (w >= 4) {
        const int lw = w - 4;
        float* const sso = (float*)(ws + WS_G) + (size_t)(b * SEQ + 16 * lw + (lane & 15)) * 16 + hh;
        bf16* const yrow = (bf16*)(ws + WS_O) + (size_t)(b * SEQ + 16 * lw + (lane >> 4)) * D + hh * HD + 8 * (lane & 15);
#define DMA_A(nn) do { const unsigned char* src_ = gb + (size_t)(nn) * UNIT_BYTES; LAS unsigned char* dst_ = lds + SC_A + ((nn) & 1) * A_BYTES; \
        _Pragma("unroll") for (int f_ = 0; f_ < 8; ++f_) __builtin_amdgcn_global_load_lds((const unsigned*)(src_ + (lw + 4 * f_) * 1024 + lane * 16), (LAS unsigned*)(dst_ + (lw + 4 * f_) * 1024), 16, 0, 0); \
        _Pragma("unroll") for (int f_ = 0; f_ < 4; ++f_) __builtin_amdgcn_global_load_lds((const unsigned*)(src_ + OFF_U + (lw + 4 * f_) * 1024 + lane * 16), (LAS unsigned*)(dst_ + 32768 + (lw + 4 * f_) * 1024), 16, 0, 0); } while (0)
#define DMA_B(nn) do { const unsigned char* src_ = gb + (size_t)(nn) * UNIT_BYTES; LAS unsigned char* dst_ = lds + SC_B + ((nn) & 1) * B_BYTES; const int fa_ = (lw + 4 < 6) ? lw + 4 : lw; \
        _Pragma("unroll") for (int f_ = 0; f_ < 4; ++f_) __builtin_amdgcn_global_load_lds((const unsigned*)(src_ + OFF_KE + (lw + 4 * f_) * 1024 + lane * 16), (LAS unsigned*)(dst_ + (lw + 4 * f_) * 1024), 16, 0, 0); \
        __builtin_amdgcn_global_load_lds((const unsigned*)(src_ + OFF_ATT + lw * 1024 + lane * 16), (LAS unsigned*)(dst_ + 16384 + lw * 1024), 16, 0, 0); \
        __builtin_amdgcn_global_load_lds((const unsigned*)(src_ + OFF_ATT + fa_ * 1024 + lane * 16), (LAS unsigned*)(dst_ + 16384 + fa_ * 1024), 16, 0, 0); } while (0)
        DMA_A(0); DMA_B(0); DMA_A(1);
        asm volatile("s_waitcnt vmcnt(12) lgkmcnt(0)" ::: "memory"); SCAN_BAR();
        for (int n = 0; n < 64; ++n) {
            v4u orow[4]; float ssq = 0.f;
            if (n > 0) {
#pragma unroll
                for (int i = 0; i < 4; ++i) orow[i] = *(const LAS v4u*)(lds + SC_OST + (16 * lw + 4 * i + (lane >> 4)) * OST_STRIDE + 16 * (lane & 15));
                const LAS float* sx = (const LAS float*)(lds + SC_SSX + ((n - 1) & 1) * 1024) + 16 * lw + (lane & 15); ssq = (sx[0] + sx[64]) + (sx[128] + sx[192]);
            }
            if (n + 1 < 64) DMA_B(n + 1);
            if (n > 0) {
                bf16* yr = yrow + (size_t)((n - 1) * 64) * D;
#pragma unroll
                for (int i = 0; i < 4; ++i) *(v4u*)(yr + (size_t)(4 * i) * D) = orow[i];
                if (lane < 16) sso[(size_t)((n - 1) * 64) * 16] = ssq;
            }
            if (n >= 2 && n + 1 < 64) asm volatile("s_waitcnt vmcnt(28) lgkmcnt(0)" ::: "memory"); else asm volatile("s_waitcnt vmcnt(0) lgkmcnt(0)" ::: "memory");
            SCAN_BAR();
            if (n + 2 < 64) DMA_A(n + 2);
            if (n >= 1 && n + 2 < 64) asm volatile("s_waitcnt vmcnt(23)" ::: "memory"); else asm volatile("s_waitcnt vmcnt(0)" ::: "memory");
            SCAN_BAR();
        }
        {
            v4u orow[4];
#pragma unroll
            for (int i = 0; i < 4; ++i) orow[i] = *(const LAS v4u*)(lds + SC_OST + (16 * lw + 4 * i + (lane >> 4)) * OST_STRIDE + 16 * (lane & 15));
            bf16* yr = yrow + (size_t)(63 * 64) * D;
#pragma unroll
            for (int i = 0; i < 4; ++i) *(v4u*)(yr + (size_t)(4 * i) * D) = orow[i];
            const LAS float* sx = (const LAS float*)(lds + SC_SSX + (63 & 1) * 1024) + 16 * lw + (lane & 15);
            if (lane < 16) sso[(size_t)(63 * 64) * 16] = (sx[0] + sx[64]) + (sx[128] + sx[192]);
        }
#undef DMA_A
#undef DMA_B
        return;
    }
    const float decv = ((const float*)(ws + WS_BETA))[bh * 64 + lane];
    f32x16 S[4];
#pragma unroll
    for (int d = 0; d < 4; ++d) S[d] = zero16();
    asm volatile("s_waitcnt vmcnt(0) lgkmcnt(0)" ::: "memory"); SCAN_BAR();
    for (int n = 0; n < 64; ++n) {
        const LAS unsigned char* buf = lds + SC_A + (n & 1) * A_BYTES; const LAS unsigned char* bbuf = lds + SC_B + (n & 1) * B_BYTES; const LAS unsigned char* ubuf = buf + 32768 + (w * 2) * 1024 + lane * 16;
        const float dec0 = __shfl(decv, n);
        f32x16 P0 = unpack16(*(const LAS bf16x8*)(ubuf), *(const LAS bf16x8*)(ubuf + 1024)), P1 = unpack16(*(const LAS bf16x8*)(ubuf + 8192), *(const LAS bf16x8*)(ubuf + 8192 + 1024));
        f32x16 O0 = zero16(), O1 = zero16();
#define FR(off, idx) (*(const LAS bf16x8*)(buf + (off) + (idx) * 1024 + lane * 16))
#define FB(off, idx) (*(const LAS bf16x8*)(bbuf + (off) + (idx) * 1024 + lane * 16))
        bf16x8 fa[4], fb[4];
#define LDPO(dst, t) do { (dst)[0] = FR(0, (((t) >> 1) * 2 + 0) * 2 + ((t) & 1)); (dst)[1] = FR(0, (((t) >> 1) * 2 + 1) * 2 + ((t) & 1)); \
                          (dst)[2] = FR(16384, (((t) >> 1) * 2 + 0) * 2 + ((t) & 1)); (dst)[3] = FR(16384, (((t) >> 1) * 2 + 1) * 2 + ((t) & 1)); __builtin_amdgcn_sched_barrier(0); } while (0)
#define MMPO(src, t) do { const bf16x8 sb = PACK_STEP(S[(t) >> 1], (t) & 1); P0 = MFMA32((src)[0], sb, P0); P1 = MFMA32((src)[1], sb, P1); O0 = MFMA32(sb, (src)[2], O0); O1 = MFMA32(sb, (src)[3], O1); __builtin_amdgcn_sched_barrier(0); } while (0)
        LDPO(fa, 0);
        LDPO(fb, 1); MMPO(fa, 0); LDPO(fa, 2); MMPO(fb, 1); LDPO(fb, 3); MMPO(fa, 2); LDPO(fa, 4); MMPO(fb, 3);
        LDPO(fb, 5); MMPO(fa, 4); LDPO(fa, 6); MMPO(fb, 5); LDPO(fb, 7); MMPO(fa, 6); MMPO(fb, 7);
        float dec = dec0; asm volatile("" : "+v"(dec) : "v"(P0[15]), "v"(P1[15]));
        const bf16x8 v00 = PACK_STEP(P0, 0), v01 = PACK_STEP(P0, 1), v10 = PACK_STEP(P1, 0), v11 = PACK_STEP(P1, 1);
        asm volatile("s_waitcnt lgkmcnt(0)" ::: "memory"); SCAN_BAR();
#define LDKE(dst, d) do { (dst)[0] = FB(0, ((d) * 2 + 0) * 2 + 0); (dst)[1] = FB(0, ((d) * 2 + 0) * 2 + 1); (dst)[2] = FB(0, ((d) * 2 + 1) * 2 + 0); (dst)[3] = FB(0, ((d) * 2 + 1) * 2 + 1); __builtin_amdgcn_sched_barrier(0); } while (0)
#define MMKE(src, d) do { _Pragma("unroll") for (int i_ = 0; i_ < 16; ++i_) S[d][i_] *= dec; \
        S[d] = MFMA32((src)[0], v00, S[d]); S[d] = MFMA32((src)[1], v01, S[d]); S[d] = MFMA32((src)[2], v10, S[d]); S[d] = MFMA32((src)[3], v11, S[d]); __builtin_amdgcn_sched_barrier(0); } while (0)
        LDKE(fa, 0);
        LDKE(fb, 1); MMKE(fa, 0); LDKE(fa, 2); MMKE(fb, 1); LDKE(fb, 3); MMKE(fa, 2);
        const bf16x8 at0 = FB(16384, 0), at1 = FB(16384, 1), at2 = FB(16384, 2), at3 = FB(16384, 3), at4 = FB(16384, 4), at5 = FB(16384, 5); __builtin_amdgcn_sched_barrier(0); MMKE(fb, 3);
        O0 = MFMA32(v00, at0, O0); O0 = MFMA32(v01, at1, O0);
        O1 = MFMA32(v00, at2, O1); O1 = MFMA32(v01, at3, O1);
        O1 = MFMA32(v10, at4, O1); O1 = MFMA32(v11, at5, O1);
#undef LDPO
#undef MMPO
#undef LDKE
#undef MMKE
#undef FR
#undef FB
        { float q0 = 0.f, q1 = 0.f;
#pragma unroll
          for (int i = 0; i < 16; ++i) { q0 += O0[i] * O0[i]; q1 += O1[i] * O1[i]; }
          q0 += __shfl_xor(q0, 32); q1 += __shfl_xor(q1, 32);
          ((LAS float*)(lds + SC_SSX + (n & 1) * 1024))[w * 64 + lane] = h ? q1 : q0; }
        { LAS unsigned char* ot = lds + SC_OST + c * OST_STRIDE + (32 * w + 4 * h) * 2;
#pragma unroll
          for (int g4 = 0; g4 < 4; ++g4) { v2u a, bq; a.x = cvtpk(O0[4 * g4], O0[4 * g4 + 1]); a.y = cvtpk(O0[4 * g4 + 2], O0[4 * g4 + 3]); bq.x = cvtpk(O1[4 * g4], O1[4 * g4 + 1]); bq.y = cvtpk(O1[4 * g4 + 2], O1[4 * g4 + 3]);
              *(LAS v2u*)(ot + 16 * g4) = a; *(LAS v2u*)(ot + 32 * OST_STRIDE + 16 * g4) = bq; } }
        asm volatile("s_waitcnt lgkmcnt(0)" ::: "memory"); SCAN_BAR();
    }
}
#define XB_TMO      128
#define XB_XCNT(j)  (256  + 64 * (j))
#define XB_XSUB(j)  (1280 + 64 * (j))
#define XB_XGEN(j)  (2304 + 64 * (j))
#define XB_TOP      3328
#define XB_TOPGEN   3392
#define XCD_BAR_WORDS 3456
#define XB_SPIN_CAP (1u << 18)

__device__ __forceinline__ unsigned xb_ld(unsigned* p)              { return __hip_atomic_load(p, __ATOMIC_RELAXED, __HIP_MEMORY_SCOPE_AGENT); }
__device__ __forceinline__ unsigned xb_add(unsigned* p, unsigned v) { return __hip_atomic_fetch_add(p, v, __ATOMIC_RELAXED, __HIP_MEMORY_SCOPE_AGENT); }
__device__ __forceinline__ unsigned xb_xcc_id() { return (unsigned)__builtin_amdgcn_s_getreg((3 << 11) | 20) & 0xFu; }
#define XB_SPIN(cond, bar) do { unsigned _sp = 0; while (cond) { __builtin_amdgcn_s_sleep(1); \
    if ((++_sp & 255u) == 0u) { if (xb_ld(&(bar)[XB_TMO])) break; if (_sp > XB_SPIN_CAP) { atomicAdd(&(bar)[XB_TMO], 1u); break; } } } } while (0)

struct XcdBarrier {
    unsigned* bar; unsigned x;
    volatile LAS unsigned* st;
};

__device__ __forceinline__ XcdBarrier xcd_barrier_post(unsigned* bar, volatile LAS unsigned* st) {
    XcdBarrier b; b.bar = bar; b.x = xb_xcc_id(); b.st = st;
    if (threadIdx.x == 0) (void)xb_add(&bar[XB_XCNT(b.x)], 1u);
    return b;
}
__device__ __forceinline__ void xcd_barrier_complete(unsigned* bar, unsigned x, unsigned& nloc, unsigned& nx) {
    const unsigned G = gridDim.x * gridDim.y * gridDim.z;
    unsigned sum, cnt, mine, sp = 0u;
    for (;;) {
        sum = 0u; cnt = 0u; mine = 0u;
#pragma unroll
        for (unsigned j = 0; j < 16; ++j) { const unsigned c = xb_ld(&bar[XB_XCNT(j)]); sum += c; cnt += (c > 0u) ? 1u : 0u; mine = (j == x) ? c : mine; }
        if (sum == G) break;
        __builtin_amdgcn_s_sleep(1);
        if ((++sp & 255u) == 0u) { if (xb_ld(&bar[XB_TMO])) break; if (sp > XB_SPIN_CAP) { atomicAdd(&bar[XB_TMO], 1u); break; } }
    }
    nloc = mine > 0u ? mine : 1u; nx = cnt > 0u ? cnt : 1u;
}

__device__ __forceinline__ void xcd_barrier(const XcdBarrier& b) {
    asm volatile("s_waitcnt vmcnt(0)" ::: "memory");
    __syncthreads();
    if (threadIdx.x == 0) {
        unsigned* bar = b.bar;
        __builtin_amdgcn_s_waitcnt(0);
        unsigned nloc = b.st[0], nx = b.st[1];
        if (nloc == 0u) { xcd_barrier_complete(bar, b.x, nloc, nx); b.st[0] = nloc; b.st[1] = nx; }
        const unsigned old = xb_add(&bar[XB_XSUB(b.x)], 1u);
        const unsigned gen = old / nloc;
        if (old + 1u == (gen + 1u) * nloc) {
            __builtin_amdgcn_fence(__ATOMIC_RELEASE, "agent");
            asm volatile("s_waitcnt vmcnt(0)" ::: "memory");
            const unsigned og = xb_add(&bar[XB_TOP], 1u);
            const unsigned tg = og / nx;
            if (og + 1u == (tg + 1u) * nx) xb_add(&bar[XB_TOPGEN], 1u);
            else XB_SPIN(xb_ld(&bar[XB_TOPGEN]) == tg, bar);
            __builtin_amdgcn_fence(__ATOMIC_ACQUIRE, "agent");
            xb_add(&bar[XB_XGEN(b.x)], 1u);
            asm volatile("s_waitcnt vmcnt(0)" ::: "memory");
        } else {
            XB_SPIN(xb_ld(&bar[XB_XGEN(b.x)]) == gen, bar);
            __builtin_amdgcn_fence(__ATOMIC_ACQUIRE, "agent");
            asm volatile("s_waitcnt vmcnt(0)" ::: "memory");
        }
    }
    __syncthreads();
}
constexpr int RING_BYTES = 131072;
constexpr int MISC_OFF = 162880;
constexpr int LDS_BYTES = 163840;
constexpr int CW_BAR = 4096;
constexpr size_t CTL_ZERO_BYTES = 1 * MiB;

#define GRID_BAR() xcd_barrier(bar)
#define WSB(off) ((bf16*)(wsp(T) + (off)))
#define OPQ(x) opq_s((int)(x))
DI int opq_s(int x) { asm volatile("" : "+s"(x)); return x; }
template <int l> DI void layer_body(PTab T, LAS unsigned char* lds, const XcdBarrier& bar) {
        ph_rmsnorm_bf16(l == 0 ? inp(T, I_X) : outp(T), inp(T, I_NMW) + l * D, WSB(WS_H));
        GRID_BAR();
        ph_ba(T, l, lds);
        { pg8::Gemm g{WSB(WS_H), WSB(WS_WIN) + (size_t)(l & 1) * NIN * D, M, NPROJ, D, D, D, 0};
          pg8::StaticOrderIn S; S.init(M, NPROJ, OPQ(gridDim.x), OPQ(blockIdx.x)); pg8::EpiProj E{WSB(WS_PROJ), NPO};
          pg8::gemm_phase<pg8::EpiProj, pg8::StaticOrderIn, true, true>(lds, g, S, E); }
        GRID_BAR();
        ph_pooled(T);
        ph_gdn_chunks(T, l, lds);
        GRID_BAR();
        if (blockIdx.x < BATCH * NH) ph_gdn_scan(T, lds, blockIdx.x);
        else { pg8::Gemm g{WSB(WS_POOLED), WSB(WS_WPL) + (size_t)(l & 1) * D * 512, M, D, 512, D, 512, 2};
          pg8::StaticOrder S; S.init(M, D, OPQ(gridDim.x) - BATCH * NH, OPQ(blockIdx.x) - BATCH * NH); pg8::EpiPool E{WSB(WS_YB), D, inp(T, I_PS) + l * D, WSB(WS_PROJ) + C_GB, NPO};
          pg8::gemm_phase<pg8::EpiPool, pg8::StaticOrder, true, true>(lds, g, S, E);
          __syncthreads(); ph_convert(T, lds, l * IT_LAYER + IT_FIRST, l + 1 < DEPTH ? (l + 1) * IT_LAYER + IT_FIRST : DEPTH * IT_LAYER, BATCH * NH); }
        GRID_BAR();
        ph_mix(T, l);
        GRID_BAR();
        { pg8::Gemm g{WSB(WS_MIXED), WSB(WS_WOUT) + (size_t)(l & 1) * D * D, M, D, D, D, D, 0};
          pg8::StaticOrder S; S.init(M, D, OPQ(gridDim.x), OPQ(blockIdx.x)); pg8::EpiResF32 E{l == 0 ? inp(T, I_X) : outp(T), outp(T), D};
          pg8::gemm_phase<pg8::EpiResF32, pg8::StaticOrder, true, true>(lds, g, S, E); }
        GRID_BAR();
        ph_rmsnorm_bf16(outp(T), inp(T, I_NFW) + l * D, WSB(WS_H));
        GRID_BAR();
        { pg8::Gemm g{WSB(WS_H), WSB(WS_WUP) + (size_t)(l & 1) * 2 * DFF * D, M, 2 * DFF, D, D, D, 0};
          pg8::StaticOrder S; S.init(M, 2 * DFF, OPQ(gridDim.x), OPQ(blockIdx.x));
          pg8::EpiGlu E{WSB(WS_BIG2), inp(T, I_CFW) + (size_t)l * 3 * DFF, inp(T, I_CFB) + (size_t)l * DFF, (float*)(wsp(T) + WS_EDGE), (LAS float*)(lds + RING_BYTES), DFF};
          pg8::gemm_phase<pg8::EpiGlu, pg8::StaticOrder, true, true>(lds, g, S, E); }
        GRID_BAR();
        ph_glu_fix(T, l);
        GRID_BAR();
        { pg8::Gemm g{WSB(WS_BIG2), WSB(WS_WDN) + (size_t)(l & 1) * D * DFF, M, D, DFF, DFF, DFF, 0};
          pg8::StaticOrder S; S.init(M, D, OPQ(gridDim.x), OPQ(blockIdx.x)); pg8::EpiResF32 E{outp(T), outp(T), D};
          pg8::gemm_phase<pg8::EpiResF32, pg8::StaticOrder, true, true>(lds, g, S, E); }
        GRID_BAR();
}
static_assert(SC_END <= MISC_OFF && L_VEC + 5 * 256 <= MISC_OFF && RING_BYTES + 4096 <= MISC_OFF, "LDS map");
constexpr int TAB_OFF = MISC_OFF + 256;
__global__ void __launch_bounds__(NTHREADS, 2) mega_fwd(Ctx c) {
    extern __shared__ __attribute__((aligned(16))) unsigned char lds_raw[];
    LAS unsigned char* lds = (LAS unsigned char*)lds_raw;
    for (int u = threadIdx.x; u < (LDS_BYTES - MISC_OFF) / 4; u += NTHREADS) ((LAS unsigned*)(lds + MISC_OFF))[u] = 0u;
    __syncthreads();
    if (threadIdx.x < 16) ((LAS unsigned long long*)(lds + TAB_OFF))[threadIdx.x] = (unsigned long long)c.in[threadIdx.x];
    if (threadIdx.x == 16) ((LAS unsigned long long*)(lds + TAB_OFF))[16] = (unsigned long long)c.out;
    if (threadIdx.x == 17) ((LAS unsigned long long*)(lds + TAB_OFF))[17] = (unsigned long long)c.ws;
    __syncthreads();
    const PTab T = (PTab)(lds + TAB_OFF);
    XcdBarrier bar = xcd_barrier_post((unsigned*)(wsp(T) + WS_CTL) + CW_BAR, (volatile LAS unsigned*)(lds + MISC_OFF) + 8);

    ph_convert(T, lds, 0, IT_FIRST, 0);
    GRID_BAR();
    layer_body<0>(T, lds, bar); layer_body<1>(T, lds, bar); layer_body<2>(T, lds, bar); layer_body<3>(T, lds, bar);
    const bool poison = __hip_atomic_load((unsigned*)(wsp(T) + WS_CTL) + CW_BAR + XB_TMO, __ATOMIC_RELAXED, __HIP_MEMORY_SCOPE_AGENT) != 0u;
    ph_rmsnorm_f32(outp(T), inp(T, I_NFIN), outp(T));
    if (poison) { asm volatile("s_waitcnt vmcnt(0)" ::: "memory"); float* X = outp(T); const float q = __builtin_nanf(""); for (size_t e = (size_t)blockIdx.x * NTHREADS + threadIdx.x; e < (size_t)M * D; e += (size_t)gridDim.x * NTHREADS) X[e] = q; }
#undef GRID_BAR
#undef WSB
}

extern "C" void kernel_launch(void* const* d_in, const int* in_sizes, int n_in, void* d_out, int out_size, void* d_ws, size_t ws_size, hipStream_t stream) {
    static int grid = 0;
    if (grid == 0) {
        if (n_in != 16 || out_size != M * D || ws_size < WS_END) { fprintf(stderr, "kernel_launch: unexpected shapes (n_in %d, out %d, ws %zu)\n", n_in, out_size, ws_size); grid = -1; return; }
        int dev = 0, cus = 0, per_cu = 0;
        if (hipGetDevice(&dev) != hipSuccess || hipDeviceGetAttribute(&cus, hipDeviceAttributeMultiprocessorCount, dev) != hipSuccess) { grid = -1; return; }
        if (hipFuncSetAttribute((const void*)mega_fwd, hipFuncAttributeMaxDynamicSharedMemorySize, LDS_BYTES) != hipSuccess) { fprintf(stderr, "kernel_launch: hipFuncSetAttribute failed\n"); grid = -1; return; }
        if (hipOccupancyMaxActiveBlocksPerMultiprocessor(&per_cu, (const void*)mega_fwd, NTHREADS, LDS_BYTES) != hipSuccess || per_cu < 1) fprintf(stderr, "kernel_launch: occupancy query says %d\n", per_cu);
        (void)hipGetLastError();
        grid = cus;
    }
    if (grid < 0) return;
    if (hipMemsetAsync((char*)d_ws + WS_CTL, 0, CTL_ZERO_BYTES, stream) != hipSuccess) return;
    Ctx c{};
    for (int i = 0; i < 16; ++i) c.in[i] = (const float*)d_in[i];
    c.out = (float*)d_out; c.ws = (unsigned char*)d_ws;
    hipLaunchKernelGGL(mega_fwd, dim3(grid), dim3(NTHREADS), LDS_BYTES, stream, c);
}
```
